# Optimizing an MI355X kernel written in HIP

```python
import functools
import jax, jax.numpy as jnp
from jax import lax
import numpy as np

D_MODEL = 1024
BATCH = 4
SEQ = 8192
DEPTH = 4

MEM_LEN = 256
Q_BLOCK = 128
MAX_GROUPS = 8
N_BRANCHES = 4
BRANCH_WIDTH = 256
MLA_HEADS = 4
MLA_NOPE = 64
MLA_ROPE = 32
MLA_V = 64
MLA_Q_RANK = 384
MLA_KV_RANK = 256
ROPE_THETA = 10000.0
SB_HEADS = 4
SB_HEAD_DIM = 64
FOX_HEADS = 4
FOX_HEAD_DIM = 64
MEM_HEADS = 4
MEM_HEAD_DIM = 64
MERGE_RANK = 128
RMS_EPS = 1e-6
LN_EPS = 1e-5
DEEPNORM_ALPHA = (2 * DEPTH) ** 0.25
DEEPNORM_BETA = (8 * DEPTH) ** -0.25

IN_SPLITS = (
    MLA_Q_RANK,
    MLA_KV_RANK,
    MLA_ROPE,
    3 * SB_HEADS * SB_HEAD_DIM,
    3 * FOX_HEADS * FOX_HEAD_DIM,
    FOX_HEADS,
    MEM_HEADS * MEM_HEAD_DIM,
    N_BRANCHES * BRANCH_WIDTH,
    MERGE_RANK,
)
IN_WIDTH = sum(IN_SPLITS)

kernel_name = "hybrid_mla_stickbreak_fox_memory_deepnorm"


def _split_last(t, sizes):
    out, start = [], 0
    for n in sizes:
        out.append(t[..., start:start + n])
        start += n
    return out


def _rms_norm(x, g):
    xf = x.astype(jnp.float32)
    y = xf * lax.rsqrt(jnp.mean(xf * xf, axis=-1, keepdims=True) + RMS_EPS)
    return (y * g.astype(jnp.float32)).astype(x.dtype)


def _layer_norm(x, g, b):
    xf = x.astype(jnp.float32)
    mu = jnp.mean(xf, axis=-1, keepdims=True)
    var = jnp.mean(jnp.square(xf - mu), axis=-1, keepdims=True)
    y = (xf - mu) * lax.rsqrt(var + LN_EPS)
    return (y * g.astype(jnp.float32) + b.astype(jnp.float32)).astype(x.dtype)


def _rope(x, cos, sin):
    x1, x2 = jnp.split(x, 2, axis=-1)
    return jnp.concatenate([x1 * cos - x2 * sin, x1 * sin + x2 * cos], axis=-1)


def _causal_sweep(block_fn, s):
    n_blocks = s // Q_BLOCK
    n_groups = min(MAX_GROUPS, n_blocks)
    bounds = [(g * n_blocks) // n_groups for g in range(n_groups + 1)]
    outs = []
    for g in range(n_groups):
        b0, b1 = bounds[g], bounds[g + 1]
        o = lax.map(functools.partial(block_fn, kend=b1 * Q_BLOCK), jnp.arange(b0, b1))
        nb, b, qn, h, dv = o.shape
        outs.append(o.transpose(1, 0, 2, 3, 4).reshape(b, nb * qn, h, dv))
    return jnp.concatenate(outs, axis=1)


def _causal_softmax_attention(q, k, v, log_decay=None):
    b, s, h, d = q.shape
    q = q * (d ** -0.5)
    c_t = None if log_decay is None else log_decay.transpose(0, 2, 1)

    def block(i, kend):
        start = i * Q_BLOCK
        qb = lax.dynamic_slice_in_dim(q, start, Q_BLOCK, axis=1)
        kb, vb = k[:, :kend], v[:, :kend]
        logits = jnp.einsum('bqhd,bkhd->bhqk', qb, kb, preferred_element_type=jnp.float32)
        if c_t is not None:
            cq = lax.dynamic_slice_in_dim(c_t, start, Q_BLOCK, axis=2)
            logits = logits + (cq[..., :, None] - c_t[..., None, :kend])
        causal = jnp.arange(kend)[None, :] <= (start + jnp.arange(Q_BLOCK))[:, None]
        logits = jnp.where(causal, logits, -jnp.inf)
        m = jnp.max(logits, axis=-1, keepdims=True)
        p = jnp.exp(logits - m)
        denom = jnp.sum(p, axis=-1).transpose(0, 2, 1)[..., None]
        o = jnp.einsum('bhqk,bkhd->bqhd', p.astype(v.dtype), vb, preferred_element_type=jnp.float32)
        return (o / denom).astype(v.dtype)

    return _causal_sweep(block, s)


def _stick_breaking_attention(q, k, v):
    b, s, h, d = q.shape
    q = q * (d ** -0.5)
    tri = jnp.tril(jnp.ones((Q_BLOCK, Q_BLOCK), jnp.float32))

    def block(i, kend):
        start = i * Q_BLOCK
        nk = kend // Q_BLOCK
        qb = lax.dynamic_slice_in_dim(q, start, Q_BLOCK, axis=1)
        kb, vb = k[:, :kend], v[:, :kend]
        z = jnp.einsum('bqhd,bkhd->bhqk', qb, kb, preferred_element_type=jnp.float32)
        strict = jnp.arange(kend)[None, :] < (start + jnp.arange(Q_BLOCK))[:, None]
        log_keep = jnp.where(strict, jax.nn.log_sigmoid(-z), 0.0)
        local = jnp.einsum('bhqnc,cr->bhqnr', log_keep.reshape(b, h, Q_BLOCK, nk, Q_BLOCK), tri)
        tot = local[..., 0]
        cross = lax.cumsum(tot, axis=3, reverse=True) - tot
        incl = (local + cross[..., None]).reshape(b, h, Q_BLOCK, kend)
        a = jnp.where(strict, jnp.exp(z + incl), 0.0).astype(v.dtype)
        return jnp.einsum('bhqk,bkhd->bqhd', a, vb)

    return _causal_sweep(block, s)


def _memory_attention(q, k, v):
    logits = jnp.einsum('bshd,bmhd->bhsm', q * (q.shape[-1] ** -0.5), k,
                        preferred_element_type=jnp.float32)
    p = jax.nn.softmax(logits, axis=-1).astype(v.dtype)
    return jnp.einsum('bhsm,bmhd->bshd', p, v)


def _layer(x, mem, cos, sin, w_in, q_norm, w_qb, kv_norm, w_kvb, fox_bias,
           w_mem_kv, w_merge_up, w_branch, w_out, ln_g, ln_b):
    b, s, _ = x.shape
    h = x @ w_in
    (c_q, c_kv, k_rope, sb_qkv, fox_qkv, fox_f, mem_q, gate_z, merge_r) = _split_last(h, IN_SPLITS)

    q = (_rms_norm(c_q, q_norm) @ w_qb).reshape(b, s, MLA_HEADS, MLA_NOPE + MLA_ROPE)
    q_nope, q_pe = q[..., :MLA_NOPE], q[..., MLA_NOPE:]
    q_pe = _rope(q_pe, cos[:, :, None, :], sin[:, :, None, :])
    kv = (_rms_norm(c_kv, kv_norm) @ w_kvb).reshape(b, s, MLA_HEADS, MLA_NOPE + MLA_V)
    k_nope, v_mla = kv[..., :MLA_NOPE], kv[..., MLA_NOPE:]
    k_pe = _rope(k_rope[:, :, None, :], cos[:, :, None, :], sin[:, :, None, :])
    k_pe = jnp.broadcast_to(k_pe, (b, s, MLA_HEADS, MLA_ROPE))
    y_mla = _causal_softmax_attention(jnp.concatenate([q_nope, q_pe], -1),
                                      jnp.concatenate([k_nope, k_pe], -1), v_mla)

    sq, sk, sv = [t.reshape(b, s, SB_HEADS, SB_HEAD_DIM) for t in jnp.split(sb_qkv, 3, axis=-1)]
    y_sb = _stick_breaking_attention(sq, sk, sv)

    fq, fk, fv = [t.reshape(b, s, FOX_HEADS, FOX_HEAD_DIM) for t in jnp.split(fox_qkv, 3, axis=-1)]
    log_f = jax.nn.log_sigmoid(fox_f.astype(jnp.float32) + fox_bias.astype(jnp.float32))
    c = jnp.cumsum(log_f, axis=1)
    y_fox = _causal_softmax_attention(fq, fk, fv, log_decay=c)

    mk, mv = jnp.split(mem @ w_mem_kv, 2, axis=-1)
    mk = mk.reshape(b, MEM_LEN, MEM_HEADS, MEM_HEAD_DIM)
    mv = mv.reshape(b, MEM_LEN, MEM_HEADS, MEM_HEAD_DIM)
    y_mem = _memory_attention(mem_q.reshape(b, s, MEM_HEADS, MEM_HEAD_DIM), mk, mv)

    branches = (y_mla, y_sb, y_fox, y_mem)
    gate_z = gate_z.reshape(b, s, N_BRANCHES, BRANCH_WIDTH)
    merge_g = jax.nn.sigmoid(merge_r @ w_merge_up).reshape(b, s, N_BRANCHES, D_MODEL)
    merged = jnp.zeros_like(x)
    for n in range(N_BRANCHES):
        yb = branches[n].reshape(b, s, BRANCH_WIDTH) * jax.nn.silu(gate_z[:, :, n])
        merged = merged + merge_g[:, :, n] * (yb @ w_branch[n])
    out = merged @ w_out

    return _layer_norm(DEEPNORM_ALPHA * x + out, ln_g, ln_b)


def setup_inputs(seed: int = 0) -> dict:
    key = jax.random.key(seed)
    ks = jax.random.split(key, 16)
    f32 = jnp.float32

    def nrm(k, shape, scale):
        return jax.random.normal(k, shape, f32) * scale

    x = nrm(ks[0], (BATCH, SEQ, D_MODEL), 1.0)
    mem = nrm(ks[1], (BATCH, MEM_LEN, D_MODEL), 1.0)
    offsets = jax.random.randint(ks[2], (BATCH, 1), 0, 4096, dtype=jnp.int32)
    positions = (jnp.arange(SEQ, dtype=jnp.int32)[None, :] + offsets).astype(jnp.int32)

    w_in = nrm(ks[3], (DEPTH, D_MODEL, IN_WIDTH), D_MODEL ** -0.5)
    mla_q_norm = 1.0 + nrm(ks[4], (DEPTH, MLA_Q_RANK), 0.02)
    mla_w_qb = nrm(ks[5], (DEPTH, MLA_Q_RANK, MLA_HEADS * (MLA_NOPE + MLA_ROPE)), MLA_Q_RANK ** -0.5)
    mla_kv_norm = 1.0 + nrm(ks[6], (DEPTH, MLA_KV_RANK), 0.02)
    mla_w_kvb = nrm(ks[7], (DEPTH, MLA_KV_RANK, MLA_HEADS * (MLA_NOPE + MLA_V)), MLA_KV_RANK ** -0.5)
    fox_forget_bias = jax.random.uniform(ks[8], (DEPTH, FOX_HEADS), f32, 1.0, 4.0)
    w_mem_kv = nrm(ks[9], (DEPTH, D_MODEL, 2 * MEM_HEADS * MEM_HEAD_DIM), D_MODEL ** -0.5)
    w_merge_up = nrm(ks[10], (DEPTH, MERGE_RANK, N_BRANCHES * D_MODEL), MERGE_RANK ** -0.5)
    w_branch = nrm(ks[11], (DEPTH, N_BRANCHES, BRANCH_WIDTH, D_MODEL), BRANCH_WIDTH ** -0.5 * DEEPNORM_BETA)
    w_out = nrm(ks[12], (DEPTH, D_MODEL, D_MODEL), D_MODEL ** -0.5 * DEEPNORM_BETA)
    ln_gain = 1.0 + nrm(ks[13], (DEPTH, D_MODEL), 0.02)
    ln_bias = nrm(ks[14], (DEPTH, D_MODEL), 0.02)
    return {"x": x, "mem": mem, "positions": positions, "w_in": w_in,
            "mla_q_norm": mla_q_norm, "mla_w_qb": mla_w_qb,
            "mla_kv_norm": mla_kv_norm, "mla_w_kvb": mla_w_kvb,
            "fox_forget_bias": fox_forget_bias, "w_mem_kv": w_mem_kv,
            "w_merge_up": w_merge_up, "w_branch": w_branch, "w_out": w_out,
            "ln_gain": ln_gain, "ln_bias": ln_bias}


def reference(x, mem, positions, w_in, mla_q_norm, mla_w_qb, mla_kv_norm, mla_w_kvb,
              fox_forget_bias, w_mem_kv, w_merge_up, w_branch, w_out, ln_gain, ln_bias):
    inv_freq = ROPE_THETA ** (-jnp.arange(0, MLA_ROPE, 2, dtype=jnp.float32) / MLA_ROPE)
    ang = positions.astype(jnp.float32)[..., None] * inv_freq
    cos = jnp.cos(ang).astype(x.dtype)
    sin = jnp.sin(ang).astype(x.dtype)
    for l in range(DEPTH):
        x = _layer(x, mem, cos, sin, w_in[l], mla_q_norm[l], mla_w_qb[l],
                   mla_kv_norm[l], mla_w_kvb[l], fox_forget_bias[l], w_mem_kv[l],
                   w_merge_up[l], w_branch[l], w_out[l], ln_gain[l], ln_bias[l])
    return x
```

```cpp
#include <hip/hip_runtime.h>
#include <hip/hip_cooperative_groups.h>
#include <cstdio>
#include <cstdint>
namespace cg = cooperative_groups;

#ifndef MK_MULTI
#define MK_MULTI 0
#endif

#ifndef REP1
#define REP1 1
#endif
#ifndef REP2
#define REP2 1
#endif
#ifndef REP3
#define REP3 1
#endif
#ifndef REP4
#define REP4 1
#endif
#define DI __device__ __forceinline__
typedef unsigned short bf16_t;
typedef short bf16x8 __attribute__((ext_vector_type(8)));
typedef short s16x4 __attribute__((ext_vector_type(4)));
typedef float f32x16 __attribute__((ext_vector_type(16)));
typedef float f32x4 __attribute__((ext_vector_type(4)));
typedef float f32x2 __attribute__((ext_vector_type(2)));
typedef unsigned u32x4 __attribute__((ext_vector_type(4)));
typedef unsigned u32x2 __attribute__((ext_vector_type(2)));
typedef __bf16 bf2_t __attribute__((ext_vector_type(2)));

constexpr int S_ = 8192, T_ = 4 * 8192, NIN = 3840;
constexpr float LOG2E = 1.4426950408889634f;
constexpr float DN_ALPHA = 1.681792830507429f;

constexpr size_t SZ_WIN = (size_t)NIN * 1024 * 2, SZ_WQB = 512 * 384 * 2  , SZ_WKVB = 512 * 256 * 2, SZ_WMEM = 512 * 1024 * 2,
                 SZ_WMU = 4096 * 128 * 2, SZ_WBR = 1024 * 1024 * 2, SZ_WOUT = 1024 * 1024 * 2;
constexpr size_t O_WIN = 0;
constexpr size_t O_WQB = O_WIN + 4 * SZ_WIN;
constexpr size_t O_WKVB = O_WQB + 4 * SZ_WQB;
constexpr size_t O_WMEM = O_WKVB + 4 * SZ_WKVB;
constexpr size_t O_WMU = O_WMEM + 4 * SZ_WMEM;
constexpr size_t O_WBR = O_WMU + 4 * SZ_WMU;
constexpr size_t O_WOUT = O_WBR + 4 * SZ_WBR;
constexpr size_t O_XB = O_WOUT + 4 * SZ_WOUT;
constexpr size_t O_CQ = O_XB + (size_t)T_ * 1024 * 2;
constexpr size_t O_CKV = O_CQ + (size_t)T_ * 384 * 2;
constexpr size_t O_SBQ = O_CKV + (size_t)T_ * 256 * 2;
constexpr size_t O_SBK = O_SBQ + (size_t)T_ * 256 * 2;
constexpr size_t O_SBVT = O_SBK + (size_t)T_ * 256 * 2;
constexpr size_t O_FQ = O_SBVT + (size_t)T_ * 256 * 2;
constexpr size_t O_FK = O_FQ + (size_t)T_ * 256 * 2;
constexpr size_t O_FVT = O_FK + (size_t)T_ * 256 * 2;
constexpr size_t O_MEMQ = O_FVT + (size_t)T_ * 256 * 2;
constexpr size_t O_GATE = O_MEMQ + (size_t)T_ * 256 * 2;
constexpr size_t O_MR = O_GATE + (size_t)T_ * 1024 * 2;
constexpr size_t O_TAIL = O_MR + (size_t)T_ * 128 * 2;
constexpr size_t O_FL = O_TAIL + (size_t)T_ * 32 * 4;
constexpr size_t O_MQ = O_FL + (size_t)T_ * 4 * 4;
constexpr size_t O_MK = O_MQ + (size_t)T_ * 384 * 2;
constexpr size_t O_MVT = O_MK + (size_t)T_ * 384 * 2;
constexpr size_t O_FC = O_MVT + (size_t)T_ * 256 * 2;
constexpr size_t O_MEMB = O_FC + (size_t)T_ * 4 * 4;
constexpr size_t O_MEMK = O_MEMB + (size_t)1024 * 1024 * 2;
constexpr size_t O_MEMVT = O_MEMK + (size_t)16 * 256 * 64 * 2;
constexpr size_t O_STATS = O_MEMVT + (size_t)16 * 256 * 64 * 2;
constexpr size_t O_COS = O_STATS + (size_t)T_ * 2 * 4;
constexpr size_t O_SIN = O_COS + (size_t)T_ * 16 * 4;
constexpr size_t O_CNT = O_SIN + (size_t)T_ * 16 * 4;
constexpr size_t O_KMAX = O_CNT + 256;
constexpr size_t O_BAR = O_KMAX + 256;
constexpr size_t O_YB = O_BAR + 3456 * 4 + 256 - (3456 * 4) % 256;
constexpr size_t O_END = O_YB + (size_t)T_ * 1024 * 2;

struct Params {
    const float* x; const float* mem; const int* pos; const float* w_in; const float* q_norm; const float* w_qb; const float* kv_norm;
    const float* w_kvb; const float* fox_bias; const float* w_mem_kv; const float* w_merge_up; const float* w_branch; const float* w_out;
    const float* ln_g; const float* ln_b; float* out; unsigned char* ws;
};

DI unsigned pk2(float a, float b) { f32x2 v = {a, b}; return __builtin_bit_cast(unsigned, __builtin_convertvector(v, bf2_t)); }
DI bf16_t tobf(float a) { return (bf16_t)(pk2(a, 0.f) & 0xffffu); }
DI float bflo(unsigned u) { return __uint_as_float(u << 16); }
DI float bfhi(unsigned u) { return __uint_as_float(u & 0xffff0000u); }
DI int tid_op() { int t = threadIdx.x & 255; asm volatile("" : "+v"(t)); return t; }
DI int tid8_op() { int t = threadIdx.x; asm volatile("" : "+v"(t)); return t; }
DI int vhalf() { return __builtin_amdgcn_readfirstlane((int)(threadIdx.x >> 8)); }
#define VB ((int)blockIdx.x * 2 + vhalf())
#define VG ((int)gridDim.x * 2)
DI unsigned xb_xcc_id() { return (unsigned)__builtin_amdgcn_readfirstlane((int)(__builtin_amdgcn_s_getreg((3 << 11) | 20) & 0xFu)); }
DI float xhalf_max(float x) { auto r = __builtin_amdgcn_permlane32_swap(__float_as_uint(x), __float_as_uint(x), false, false); return fmaxf(__uint_as_float(r[0]), __uint_as_float(r[1])); }
DI float xhalf_other(float x, int h) { auto r = __builtin_amdgcn_permlane32_swap(__float_as_uint(x), __float_as_uint(x), false, false); return h ? __uint_as_float(r[0]) : __uint_as_float(r[1]); }
DI int crow(int i, int h) { return (i & 3) + 8 * (i >> 2) + 4 * h; }
#define MFMA32(a, b, c) __builtin_amdgcn_mfma_f32_32x32x16_bf16((a), (b), (c), 0, 0, 0)
DI float fexp2(float x) { return __builtin_amdgcn_exp2f(x); }
DI float flog2(float x) { return __builtin_amdgcn_logf(x); }
DI void zero4(f32x16 (&a)[2][2]) {
#pragma unroll
    for (int i = 0; i < 2; ++i)
#pragma unroll
        for (int j = 0; j < 2; ++j)
#pragma unroll
            for (int k = 0; k < 16; ++k) a[i][j][k] = 0.f;
}

constexpr int LS = 72;
constexpr int TILE_E = 128 * LS;
constexpr int SMEM_GEMM = 4 * TILE_E * 2;
constexpr int SMEM_RS = SMEM_GEMM;
constexpr int SMEM_ITEM = SMEM_GEMM + 512;
constexpr int SMEM_FLAG = SMEM_GEMM + 640;
constexpr int SMEM_TOTAL = SMEM_GEMM + 1024;
constexpr int HALF_SMEM = SMEM_TOTAL;

DI void g_load(u32x4 (&ra)[4], u32x4 (&rb)[4], const bf16_t* A, unsigned oa, unsigned sa, const bf16_t* Bt, unsigned ob, unsigned sb) {
#pragma unroll
    for (int j = 0; j < 4; ++j) {
        ra[j] = *(const u32x4*)((const unsigned char*)A + (oa + j * sa));
        rb[j] = *(const u32x4*)((const unsigned char*)Bt + (ob + j * sb));
    }
}
DI void g_store(const u32x4 (&ra)[4], const u32x4 (&rb)[4], bf16_t* sa, bf16_t* sb, int tid) {
#pragma unroll
    for (int j = 0; j < 4; ++j) {
        const int c = tid + 256 * j, row = c >> 3, kc = (c & 7) * 8;
        *(u32x4*)(sa + row * LS + kc) = ra[j];
        *(u32x4*)(sb + row * LS + kc) = rb[j];
    }
}
DI void gemm_accum(f32x16 (&acc)[2][2], const bf16_t* A, int lda, const bf16_t* Bt, int ldb, int nk, unsigned char* smem) {
    const int tid = tid_op(), lane = tid & 63, w = tid >> 6, wr = w >> 1, wc = w & 1, r = lane & 31, h = lane >> 5;
    bf16_t* sA = (bf16_t*)smem;
    bf16_t* sB = sA + 2 * TILE_E;
    u32x4 ra[4], rb[4];
    const unsigned oa = (unsigned)(((tid >> 3) * lda + (tid & 7) * 8) * 2), ob = (unsigned)(((tid >> 3) * ldb + (tid & 7) * 8) * 2);
    const unsigned sa = (unsigned)(lda * 64), sb = (unsigned)(ldb * 64);
    g_load(ra, rb, A, oa, sa, Bt, ob, sb);
    __syncthreads();
    g_store(ra, rb, sA, sB, tid);
#pragma unroll 1
    for (int kt = 0; kt < nk; ++kt) {
        const int buf = kt & 1;
        if (kt + 1 < nk) g_load(ra, rb, A + (kt + 1) * 64, oa, sa, Bt + (kt + 1) * 64, ob, sb);
        __syncthreads();
        const bf16_t* a = sA + buf * TILE_E + (wr * 64 + r) * LS + h * 8;
        const bf16_t* b = sB + buf * TILE_E + (wc * 64 + r) * LS + h * 8;
#pragma unroll
        for (int s = 0; s < 4; ++s) {
            const bf16x8 a0 = *(const bf16x8*)(a + s * 16), a1 = *(const bf16x8*)(a + 32 * LS + s * 16);
            const bf16x8 b0 = *(const bf16x8*)(b + s * 16), b1 = *(const bf16x8*)(b + 32 * LS + s * 16);
            acc[0][0] = MFMA32(a0, b0, acc[0][0]);
            acc[0][1] = MFMA32(a0, b1, acc[0][1]);
            acc[1][0] = MFMA32(a1, b0, acc[1][0]);
            acc[1][1] = MFMA32(a1, b1, acc[1][1]);
        }
        if (kt + 1 < nk) g_store(ra, rb, sA + (buf ^ 1) * TILE_E, sB + (buf ^ 1) * TILE_E, tid);
    }
}

DI void gemm_accum_n1(f32x16 (&acc)[2], const bf16_t* A, int lda, const bf16_t* Bt, int ldb, int nk, unsigned char* smem) {
    const int tid = tid_op(), lane = tid & 63, w = tid >> 6, wr = w >> 1, wc = w & 1, r = lane & 31, h = lane >> 5;
    bf16_t* sA = (bf16_t*)smem;
    bf16_t* sB = sA + 2 * TILE_E;
    u32x4 ra[4], rb[2];
    const unsigned oa = (unsigned)(((tid >> 3) * lda + (tid & 7) * 8) * 2), ob = (unsigned)(((tid >> 3) * ldb + (tid & 7) * 8) * 2);
    const unsigned sa = (unsigned)(lda * 64), sb = (unsigned)(ldb * 64);
    const int srow = tid >> 3, skc = (tid & 7) * 8;
#pragma unroll
    for (int j = 0; j < 4; ++j) ra[j] = *(const u32x4*)((const unsigned char*)A + (oa + j * sa));
#pragma unroll
    for (int j = 0; j < 2; ++j) rb[j] = *(const u32x4*)((const unsigned char*)Bt + (ob + j * sb));
    __syncthreads();
#pragma unroll
    for (int j = 0; j < 4; ++j) *(u32x4*)(sA + (srow + 32 * j) * LS + skc) = ra[j];
#pragma unroll
    for (int j = 0; j < 2; ++j) *(u32x4*)(sB + (srow + 32 * j) * LS + skc) = rb[j];
#pragma unroll 1
    for (int kt = 0; kt < nk; ++kt) {
        const int buf = kt & 1;
        if (kt + 1 < nk) {
#pragma unroll
            for (int j = 0; j < 4; ++j) ra[j] = *(const u32x4*)((const unsigned char*)(A + (kt + 1) * 64) + (oa + j * sa));
#pragma unroll
            for (int j = 0; j < 2; ++j) rb[j] = *(const u32x4*)((const unsigned char*)(Bt + (kt + 1) * 64) + (ob + j * sb));
        }
        __syncthreads();
        const bf16_t* a = sA + buf * TILE_E + (wr * 64 + r) * LS + h * 8;
        const bf16_t* b = sB + buf * TILE_E + (wc * 32 + r) * LS + h * 8;
#pragma unroll
        for (int s = 0; s < 4; ++s) {
            const bf16x8 a0 = *(const bf16x8*)(a + s * 16), a1 = *(const bf16x8*)(a + 32 * LS + s * 16);
            const bf16x8 b0 = *(const bf16x8*)(b + s * 16);
            acc[0] = MFMA32(a0, b0, acc[0]);
            acc[1] = MFMA32(a1, b0, acc[1]);
        }
        if (kt + 1 < nk) {
#pragma unroll
            for (int j = 0; j < 4; ++j) *(u32x4*)(sA + (buf ^ 1) * TILE_E + (srow + 32 * j) * LS + skc) = ra[j];
#pragma unroll
            for (int j = 0; j < 2; ++j) *(u32x4*)(sB + (buf ^ 1) * TILE_E + (srow + 32 * j) * LS + skc) = rb[j];
        }
    }
}

template <int NB> struct Stg { u32x4 a[4]; u32x4 b[NB]; };
template <int NB> DI void stg_issue(Stg<NB>& st, const bf16_t* A, unsigned oa, unsigned sa, const bf16_t* B, unsigned ob, unsigned sb) {
#pragma unroll
    for (int j = 0; j < 4; ++j) st.a[j] = *(const u32x4*)((const unsigned char*)A + (oa + j * sa));
#pragma unroll
    for (int j = 0; j < NB; ++j) st.b[j] = *(const u32x4*)((const unsigned char*)B + (ob + j * sb));
}
template <int NB> DI void stg_commit(const Stg<NB>& st, bf16_t* sA, bf16_t* sB, int srow, int skc) {
#pragma unroll
    for (int j = 0; j < 4; ++j) *(u32x4*)(sA + (srow + 32 * j) * LS + skc) = st.a[j];
#pragma unroll
    for (int j = 0; j < NB; ++j) *(u32x4*)(sB + (srow + 32 * j) * LS + skc) = st.b[j];
}
DI void mma22(f32x16 (&acc)[2][2], const bf16_t* sA, const bf16_t* sB, int wr, int wc, int r, int h) {
    const bf16_t* a = sA + (wr * 64 + r) * LS + h * 8;
    const bf16_t* b = sB + (wc * 64 + r) * LS + h * 8;
#pragma unroll
    for (int s = 0; s < 4; ++s) {
        const bf16x8 a0 = *(const bf16x8*)(a + s * 16), a1 = *(const bf16x8*)(a + 32 * LS + s * 16);
        const bf16x8 b0 = *(const bf16x8*)(b + s * 16), b1 = *(const bf16x8*)(b + 32 * LS + s * 16);
        acc[0][0] = MFMA32(a0, b0, acc[0][0]);
        acc[0][1] = MFMA32(a0, b1, acc[0][1]);
        acc[1][0] = MFMA32(a1, b0, acc[1][0]);
        acc[1][1] = MFMA32(a1, b1, acc[1][1]);
    }
}
DI void mma21(f32x16 (&acc)[2], const bf16_t* sA, const bf16_t* sB, int wr, int wc, int r, int h) {
    const bf16_t* a = sA + (wr * 64 + r) * LS + h * 8;
    const bf16_t* b = sB + (wc * 32 + r) * LS + h * 8;
#pragma unroll
    for (int s = 0; s < 4; ++s) {
        const bf16x8 a0 = *(const bf16x8*)(a + s * 16), a1 = *(const bf16x8*)(a + 32 * LS + s * 16);
        const bf16x8 b0 = *(const bf16x8*)(b + s * 16);
        acc[0] = MFMA32(a0, b0, acc[0]);
        acc[1] = MFMA32(a1, b0, acc[1]);
    }
}

constexpr int T256_E = 256 * LS;
struct Stg8 { u32x4 a[4]; u32x4 b[4]; };
DI void stg8_issue(Stg8& st, const bf16_t* A, const bf16_t* B, unsigned oab, unsigned sab) {
#pragma unroll
    for (int j = 0; j < 4; ++j) st.a[j] = *(const u32x4*)((const unsigned char*)A + (oab + j * sab));
#pragma unroll
    for (int j = 0; j < 4; ++j) st.b[j] = *(const u32x4*)((const unsigned char*)B + (oab + j * sab));
}
DI void stg8_commit(const Stg8& st, bf16_t* sA, bf16_t* sB, int srow, int skc) {
#pragma unroll
    for (int j = 0; j < 4; ++j) *(u32x4*)(sA + (srow + 64 * j) * LS + skc) = st.a[j];
#pragma unroll
    for (int j = 0; j < 4; ++j) *(u32x4*)(sB + (srow + 64 * j) * LS + skc) = st.b[j];
}
DI void mma8(f32x16 (&acc)[2][2][2], const bf16_t* sA, const bf16_t* sB, int wr, int wc, int r, int h) {
    const bf16_t* a = sA + (wr * 128 + r) * LS + h * 8;
    const bf16_t* b = sB + (wc * 64 + r) * LS + h * 8;
#define SCHED_ __builtin_amdgcn_sched_barrier(0)
#define WAITL0_ __builtin_amdgcn_s_waitcnt(0xC07F)
#define KSTEP_(S, A0, A1, B0, B1, N0, N1, NB0, NB1)                                                                         \
    WAITL0_;                                                                                                                 \
    a2 = *(const bf16x8*)(a + 64 * LS + (S) * 16); a3 = *(const bf16x8*)(a + 96 * LS + (S) * 16);                           \
    SCHED_;                                                                                                                  \
    acc[0][0][0] = MFMA32(A0, B0, acc[0][0][0]); acc[0][0][1] = MFMA32(A0, B1, acc[0][0][1]);                                \
    acc[0][1][0] = MFMA32(A1, B0, acc[0][1][0]); acc[0][1][1] = MFMA32(A1, B1, acc[0][1][1]);                                \
    SCHED_;                                                                                                                  \
    WAITL0_;                                                                                                                 \
    if ((S) < 3) { N0 = *(const bf16x8*)(a + ((S) + 1) * 16); N1 = *(const bf16x8*)(a + 32 * LS + ((S) + 1) * 16);           \
                   NB0 = *(const bf16x8*)(b + ((S) + 1) * 16); NB1 = *(const bf16x8*)(b + 32 * LS + ((S) + 1) * 16); }       \
    SCHED_;                                                                                                                  \
    acc[1][0][0] = MFMA32(a2, B0, acc[1][0][0]); acc[1][0][1] = MFMA32(a2, B1, acc[1][0][1]);                                \
    acc[1][1][0] = MFMA32(a3, B0, acc[1][1][0]); acc[1][1][1] = MFMA32(a3, B1, acc[1][1][1]);                                \
    SCHED_;
    bf16x8 p0 = *(const bf16x8*)(a), p1 = *(const bf16x8*)(a + 32 * LS), pb0 = *(const bf16x8*)(b), pb1 = *(const bf16x8*)(b + 32 * LS);
    bf16x8 q0, q1, qb0, qb1, a2, a3;
    KSTEP_(0, p0, p1, pb0, pb1, q0, q1, qb0, qb1)
    KSTEP_(1, q0, q1, qb0, qb1, p0, p1, pb0, pb1)
    KSTEP_(2, p0, p1, pb0, pb1, q0, q1, qb0, qb1)
    KSTEP_(3, q0, q1, qb0, qb1, p0, p1, pb0, pb1)
#undef KSTEP_
#undef WAITL0_
#undef SCHED_
}

template <typename T> DI T* opaque(T* p) { asm volatile("" : "+v"(p) : : "memory"); return p; }
DI void st_rm(const f32x16 (&acc)[2][2], bf16_t* base, int ld, float scale, int r, int h) {
    bf16_t* pb = base + (size_t)(4 * h) * ld + r;
#pragma unroll
    for (int mi = 0; mi < 2; ++mi)
#pragma unroll
        for (int qd = 0; qd < 4; ++qd) {
            bf16_t* q = opaque(pb + (size_t)(32 * mi + 8 * qd) * ld);
#pragma unroll
            for (int e = 0; e < 4; ++e)
#pragma unroll
                for (int ni = 0; ni < 2; ++ni) q[(size_t)e * ld + 32 * ni] = tobf(acc[mi][ni][4 * qd + e] * scale);
        }
}
DI void st_tr(const f32x16 (&acc)[2][2], bf16_t* base, int ld, float scale, int r, int h) {
    bf16_t* pb = base + (size_t)r * ld + 4 * h;
#pragma unroll
    for (int ni = 0; ni < 2; ++ni) {
        bf16_t* q = opaque(pb + (size_t)(32 * ni) * ld);
#pragma unroll
        for (int mi = 0; mi < 2; ++mi)
#pragma unroll
            for (int qd = 0; qd < 4; ++qd) {
                u32x2 v;
                v.x = pk2(acc[mi][ni][4 * qd] * scale, acc[mi][ni][4 * qd + 1] * scale);
                v.y = pk2(acc[mi][ni][4 * qd + 2] * scale, acc[mi][ni][4 * qd + 3] * scale);
                *(u32x2*)(q + 32 * mi + 8 * qd) = v;
            }
    }
}

DI int win_src_col(int n) {
    if (n < 640) return n;
    if (n < 2176) return n + 32;
    if (n < 3584) return n + 36;
    if (n < 3616) return n - 3584 + 640;
    if (n < 3620) return n - 3616 + 2208;
    return -1;
}
DI void transpose_job(const float* src, int srcN, int K, bf16_t* dst, int Ndst, const float* rs, bool winmap, unsigned char* smem, int nvalid = 1 << 30) {
    float* tl = (float*)smem;
    const int tid = tid_op(), tx = tid & 63, ty = tid >> 6, nkt = K / 64, ntiles = nkt * (Ndst / 64);
    for (int t = VB; t < ntiles; t += VG) {
        const int k0 = (t % nkt) * 64, n0 = (t / nkt) * 64;
        const int sc = winmap ? win_src_col(n0 + tx) : ((n0 + tx) < nvalid ? (n0 + tx) : -1);
        float tv[16];
#pragma unroll
        for (int i = 0; i < 16; ++i) {
            const int kk = ty + 4 * i;
            float v = 0.f;
            if (sc >= 0) { v = src[(size_t)(k0 + kk) * srcN + sc]; if (rs) v *= rs[k0 + kk]; }
            tv[i] = v;
        }
#pragma unroll
        for (int i = 0; i < 16; ++i) tl[(ty + 4 * i) * 65 + tx] = tv[i];
        __syncthreads();
        const int rr = tid >> 2, c0 = (tid & 3) * 16;
        u32x4 o0, o1;
        o0.x = pk2(tl[(c0 + 0) * 65 + rr], tl[(c0 + 1) * 65 + rr]);   o0.y = pk2(tl[(c0 + 2) * 65 + rr], tl[(c0 + 3) * 65 + rr]);
        o0.z = pk2(tl[(c0 + 4) * 65 + rr], tl[(c0 + 5) * 65 + rr]);   o0.w = pk2(tl[(c0 + 6) * 65 + rr], tl[(c0 + 7) * 65 + rr]);
        o1.x = pk2(tl[(c0 + 8) * 65 + rr], tl[(c0 + 9) * 65 + rr]);   o1.y = pk2(tl[(c0 + 10) * 65 + rr], tl[(c0 + 11) * 65 + rr]);
        o1.z = pk2(tl[(c0 + 12) * 65 + rr], tl[(c0 + 13) * 65 + rr]); o1.w = pk2(tl[(c0 + 14) * 65 + rr], tl[(c0 + 15) * 65 + rr]);
        bf16_t* d = dst + (size_t)(n0 + rr) * K + k0 + c0;
        *(u32x4*)d = o0; *(u32x4*)(d + 8) = o1;
        __syncthreads();
    }
}
DI void cvt_job(const float* __restrict__ src, bf16_t* __restrict__ dst, size_t n8) {
    const size_t stride = (size_t)gridDim.x * 512;
    for (size_t i0 = (size_t)blockIdx.x * 512 + tid8_op(); i0 < n8; i0 += 4 * stride) {
        f32x4 a[4], b[4];
#pragma unroll
        for (int u = 0; u < 4; ++u) { const size_t i = i0 + u * stride; if (i < n8) { a[u] = *(const f32x4*)(src + i * 8); b[u] = *(const f32x4*)(src + i * 8 + 4); } }
#pragma unroll
        for (int u = 0; u < 4; ++u) { const size_t i = i0 + u * stride; if (i < n8) {
            u32x4 o; o.x = pk2(a[u].x, a[u].y); o.y = pk2(a[u].z, a[u].w); o.z = pk2(b[u].x, b[u].y); o.w = pk2(b[u].z, b[u].w);
            *(u32x4*)(dst + i * 8) = o; } }
    }
}
DI void prologue(const Params& p, unsigned char* smem) {
    unsigned char* ws = p.ws; asm volatile("" : "+s"(ws));
    { const int t0 = tid8_op(); if (blockIdx.x == 0 && t0 < 64) ((unsigned*)(ws + O_CNT))[t0] = 0u; }
    for (int l = 0; l < 4; ++l) {
        transpose_job(p.w_in + (size_t)l * 1024 * 3620, 3620, 1024, (bf16_t*)(ws + O_WIN + l * SZ_WIN), NIN, nullptr, true, smem);
        transpose_job(p.w_qb + (size_t)l * 384 * 384, 384, 384, (bf16_t*)(ws + O_WQB + l * SZ_WQB), 512, p.q_norm + l * 384, false, smem, 384);
        transpose_job(p.w_kvb + (size_t)l * 256 * 512, 512, 256, (bf16_t*)(ws + O_WKVB + l * SZ_WKVB), 512, p.kv_norm + l * 256, false, smem);
        transpose_job(p.w_mem_kv + (size_t)l * 1024 * 512, 512, 1024, (bf16_t*)(ws + O_WMEM + l * SZ_WMEM), 512, nullptr, false, smem);
        transpose_job(p.w_merge_up + (size_t)l * 128 * 4096, 4096, 128, (bf16_t*)(ws + O_WMU + l * SZ_WMU), 4096, nullptr, false, smem);
        transpose_job(p.w_branch + (size_t)l * 1024 * 1024, 1024, 1024, (bf16_t*)(ws + O_WBR + l * SZ_WBR), 1024, nullptr, false, smem);
        transpose_job(p.w_out + (size_t)l * 1024 * 1024, 1024, 1024, (bf16_t*)(ws + O_WOUT + l * SZ_WOUT), 1024, nullptr, false, smem);
    }
    cvt_job(p.x, (bf16_t*)(ws + O_XB), (size_t)T_ * 1024 / 8);
    cvt_job(p.mem, (bf16_t*)(ws + O_MEMB), (size_t)1024 * 1024 / 8);
    float* cs = (float*)(ws + O_COS); float* sn = (float*)(ws + O_SIN);
    for (int idx = blockIdx.x * 512 + tid8_op(); idx < T_ * 16; idx += gridDim.x * 512) {
        const int t = idx >> 4, i = idx & 15;
        const float inv = (float)exp2(-(double)i * (2.0 / 32.0) * 13.287712379549449);
        const float ang = (float)p.pos[t] * inv;
        const double rr = (double)ang - 6.283185307179586476925 * rint((double)ang * 0.15915494309189533577);
        const float rf = (float)rr;
        cs[idx] = cosf(rf); sn[idx] = sinf(rf);
    }
}

namespace pg8 {
#define PG8_LAS __attribute__((address_space(3)))
typedef unsigned short bf16_t;
typedef short bf16x8 __attribute__((ext_vector_type(8)));
typedef float f32x4 __attribute__((ext_vector_type(4)));
typedef unsigned u32x4 __attribute__((ext_vector_type(4)));
constexpr int BM = 256, BK = 64, HALF = 128, HTB = HALF * BK * 2  , STAGE_BYTES = 8 * HTB, NXCD = 8, WGM = 8;

__host__ __device__ __forceinline__ int lds_byte(int r, int c) { const int st = (r >> 4) * 2 + (c >> 5), rr = r & 15, cc = c & 31, ob = rr * 64 + cc * 2; return st * 1024 + (ob ^ (((ob >> 9) & 1) << 5)); }
__host__ __device__ __forceinline__ void stage_rc(int b, int& R, int& C) { const int st = b / 1024, sb = b % 1024, swz = sb ^ (((sb >> 9) & 1) << 5); R = (st >> 1) * 16 + swz / 64; C = (st & 1) * 32 + (swz % 64) / 2; }
__host__ __device__ __forceinline__ int perm32(int rho) { const int n = rho >> 4, i = rho & 15; return 8 * (i >> 2) + 4 * n + (i & 3); }

struct Unit { int pm, pn; };
struct Gemm { const bf16_t* A; const bf16_t* Bt; int M, N, K; };

struct StaticOrder {
    int nM, nN, nwg, G, c;
    __host__ __device__ void init(int M, int N, int G_, int c_) { nM = M / BM; nN = N / BM; nwg = nM * nN; G = G_; c = c_; }
    __host__ __device__ bool next(int i, Unit& u) const {
        const long L = (long)i * G + c; if (L >= nwg) return false;
        int wgid = (int)L; { const int q = nwg / NXCD, r = nwg % NXCD, xcd = wgid % NXCD, off = wgid / NXCD; wgid = (xcd < r ? xcd * (q + 1) : r * (q + 1) + (xcd - r) * q) + off; }
        const int nig = WGM * nN, gid = wgid / nig, fm = gid * WGM, gsz = (nM - fm) < WGM ? (nM - fm) : WGM;
        u.pm = fm + ((wgid % nig) % gsz); u.pn = (wgid % nig) / gsz; return true;
    }
    __device__ __forceinline__ void a_ready(const Unit&) const {}
    __device__ __forceinline__ void done(const Unit&) const {}
};

template <class Epi, class Sched, bool ALIGN_EPI = false, bool SP2 = false>
__device__ __forceinline__ void gemm_phase(PG8_LAS unsigned char* lds, const Gemm g, const Sched& S, const Epi& E) {
    const int tid = ::tid8_op(), wid = __builtin_amdgcn_readfirstlane(tid >> 6), lane = tid & 63, wr = wid >> 2, wc = wid & 3, fr = lane & 15, fq = lane >> 4;
    const int K = g.K, nt = K / BK;
    unsigned voffA[2], voffB[2];
#pragma unroll
    for (int i = 0; i < 2; ++i) { int R, C; stage_rc(tid * 16 + i * 8192, R, C); const int Rb = Epi::PERM ? ((R & ~31) + perm32(R & 31)) : R;
        voffA[i] = (unsigned)(R * K + C) * 2u; voffB[i] = (unsigned)(Rb * K + C) * 2u; }
    const size_t kstep = (size_t)(BK * 2);
    const size_t hstep = (size_t)HALF * K * 2;
    const size_t tstep = 2 * hstep;
    const unsigned ldsw = (unsigned)wid * 1024u;
    const int aoff = lds_byte(wr * 64 + fr, fq * 8), boff = lds_byte(wc * 32 + fr, fq * 8);
#define PG8_SA(b, h) (((b) * 2 + (h)) * HTB)
#define PG8_SB(b, h) ((4 + (b) * 2 + (h)) * HTB)
#define PG8_STAGE(bufoff, gbase, voff) do { _Pragma("unroll") for (int _i = 0; _i < 2; ++_i) \
        __builtin_amdgcn_global_load_lds((const unsigned*)((const char*)(gbase) + (voff)[_i]), (PG8_LAS unsigned*)(lds + (bufoff) + ldsw + _i * 8192), 16, 0, 0); } while (0)
#define PG8_LDA(dst, b, h) do { _Pragma("unroll") for (int m = 0; m < 4; ++m) _Pragma("unroll") for (int k = 0; k < 2; ++k) dst[m][k] = *(const PG8_LAS bf16x8*)(lds + PG8_SA(b, h) + aoff + m * 2048 + k * 1024); } while (0)
#define PG8_LDB(dst, b, h) do { _Pragma("unroll") for (int n = 0; n < 2; ++n) _Pragma("unroll") for (int k = 0; k < 2; ++k) dst[n][k] = *(const PG8_LAS bf16x8*)(lds + PG8_SB(b, h) + boff + n * 2048 + k * 1024); } while (0)
#define PG8_MMA(ai, bj, At, Bt) do { __builtin_amdgcn_s_setprio(1); _Pragma("unroll") for (int m = 0; m < 4; ++m) _Pragma("unroll") for (int n = 0; n < 2; ++n) _Pragma("unroll") for (int k = 0; k < 2; ++k) \
        acc[ai][bj][m][n] = __builtin_amdgcn_mfma_f32_16x16x32_bf16(Bt[n][k], At[m][k], acc[ai][bj][m][n], 0, 0, 0); __builtin_amdgcn_s_setprio(0); } while (0)
#define PG8_WAIT_V(n) asm volatile("s_waitcnt vmcnt(" #n ")" ::: "memory")
#define PG8_WAIT_L(n) asm volatile("s_waitcnt lgkmcnt(" #n ")" ::: "memory")
#define PG8_BAR __builtin_amdgcn_s_barrier()
#define PG8_SCHED __builtin_amdgcn_sched_barrier(0)
    Unit cur, nxt; int ui = 0;
    if (!S.next(0, cur)) return;
    f32x4 acc[2][2][4][2];
#pragma unroll
    for (int a = 0; a < 2; ++a)
#pragma unroll
        for (int b = 0; b < 2; ++b)
#pragma unroll
            for (int m = 0; m < 4; ++m)
#pragma unroll
                for (int n = 0; n < 2; ++n) acc[a][b][m][n] = (f32x4){0.f, 0.f, 0.f, 0.f};
    bf16x8 At[4][2], B0[2][2], B1[2][2];
    const char* cA = (const char*)g.A + (size_t)cur.pm * tstep; const char* cB = (const char*)g.Bt + (size_t)cur.pn * tstep;
    S.a_ready(cur);
    if constexpr (SP2) {
        PG8_STAGE(PG8_SB(0, 0), cB, voffB); PG8_STAGE(PG8_SB(0, 1), cB + hstep, voffB); PG8_STAGE(PG8_SA(0, 0), cA, voffA); PG8_STAGE(PG8_SA(0, 1), cA + hstep, voffA);
        if (wr == 1) PG8_BAR;
        PG8_WAIT_V(2); PG8_BAR;
        PG8_STAGE(PG8_SB(1, 0), cB + kstep, voffB); PG8_STAGE(PG8_SA(1, 0), cA + kstep, voffA); PG8_STAGE(PG8_SB(1, 1), cB + hstep + kstep, voffB);
        PG8_WAIT_V(6); PG8_BAR;
    } else {
        PG8_STAGE(PG8_SB(0, 0), cB, voffB); PG8_STAGE(PG8_SA(0, 0), cA, voffA); PG8_STAGE(PG8_SB(0, 1), cB + hstep, voffB); PG8_STAGE(PG8_SA(0, 1), cA + hstep, voffA);
        if (wr == 1) PG8_BAR;
        PG8_WAIT_V(4); PG8_BAR;
        PG8_STAGE(PG8_SB(1, 0), cB + kstep, voffB); PG8_STAGE(PG8_SA(1, 0), cA + kstep, voffA); PG8_STAGE(PG8_SB(1, 1), cB + hstep + kstep, voffB);
        PG8_WAIT_V(6); PG8_BAR;
    }
    for (;;) {
        const bool has_next = S.next(ui + 1, nxt);
        const char* nA = has_next ? (const char*)g.A + (size_t)nxt.pm * tstep : cA; const char* nB = has_next ? (const char*)g.Bt + (size_t)nxt.pn * tstep : cB;
        for (int t = 0; t < nt; t += 2) {
            const bool last = (t == nt - 2);
            const char* a1 = cA + (size_t)(t + 1) * kstep;
            const char* a2 = last ? nA : cA + (size_t)(t + 2) * kstep; const char* b2 = last ? nB : cB + (size_t)(t + 2) * kstep;
            const char* a3 = a2 + kstep; const char* b3 = b2 + kstep;
            if (last && has_next) S.a_ready(nxt);
            if constexpr (SP2) {
            PG8_LDB(B0, 0, 0); PG8_LDB(B1, 0, 1); PG8_SCHED; PG8_LDA(At, 0, 0); PG8_STAGE(PG8_SA(1, 1), a1 + hstep, voffA);
            PG8_WAIT_V(8); PG8_WAIT_L(0); PG8_BAR; PG8_MMA(0, 0, At, B0); PG8_MMA(0, 1, At, B1); PG8_BAR; PG8_SCHED;
            PG8_LDA(At, 0, 1); PG8_STAGE(PG8_SB(0, 0), b2, voffB); PG8_STAGE(PG8_SB(0, 1), b2 + hstep, voffB); PG8_STAGE(PG8_SA(0, 0), a2, voffA);
            PG8_WAIT_V(8); PG8_WAIT_L(0); PG8_BAR; PG8_MMA(1, 0, At, B0); PG8_MMA(1, 1, At, B1); PG8_BAR; PG8_SCHED;
            PG8_LDB(B0, 1, 0); PG8_LDB(B1, 1, 1); PG8_SCHED; PG8_LDA(At, 1, 0); PG8_STAGE(PG8_SA(0, 1), a2 + hstep, voffA);
            PG8_WAIT_V(8); PG8_WAIT_L(0); PG8_BAR; PG8_MMA(0, 0, At, B0); PG8_MMA(0, 1, At, B1); PG8_BAR; PG8_SCHED;
            PG8_LDA(At, 1, 1); PG8_STAGE(PG8_SB(1, 0), b3, voffB); PG8_STAGE(PG8_SB(1, 1), b3 + hstep, voffB); PG8_STAGE(PG8_SA(1, 0), a3, voffA);
            PG8_WAIT_V(8); PG8_WAIT_L(0); PG8_BAR; PG8_MMA(1, 0, At, B0); PG8_MMA(1, 1, At, B1); PG8_BAR; PG8_SCHED;
            } else {
            PG8_LDB(B0, 0, 0); PG8_SCHED; PG8_LDA(At, 0, 0); PG8_STAGE(PG8_SA(1, 1), a1 + hstep, voffA);
            PG8_WAIT_L(8); PG8_BAR; PG8_WAIT_L(0); PG8_MMA(0, 0, At, B0); PG8_BAR; PG8_SCHED;
            PG8_LDB(B1, 0, 1); PG8_STAGE(PG8_SB(0, 0), b2, voffB);
            PG8_BAR; PG8_WAIT_L(0); PG8_MMA(0, 1, At, B1); PG8_BAR;
            PG8_LDA(At, 0, 1); PG8_STAGE(PG8_SA(0, 0), a2, voffA);
            PG8_BAR; PG8_WAIT_L(0); PG8_MMA(1, 0, At, B0); PG8_BAR; PG8_SCHED;
            PG8_STAGE(PG8_SB(0, 1), b2 + hstep, voffB);
            PG8_WAIT_V(6); PG8_BAR; PG8_MMA(1, 1, At, B1); PG8_BAR;
            PG8_LDB(B0, 1, 0); PG8_SCHED; PG8_LDA(At, 1, 0); PG8_STAGE(PG8_SA(0, 1), a2 + hstep, voffA);
            PG8_WAIT_L(8); PG8_BAR; PG8_WAIT_L(0); PG8_MMA(0, 0, At, B0); PG8_BAR; PG8_SCHED;
            PG8_LDB(B1, 1, 1); PG8_STAGE(PG8_SB(1, 0), b3, voffB);
            PG8_BAR; PG8_WAIT_L(0); PG8_MMA(0, 1, At, B1); PG8_BAR;
            PG8_LDA(At, 1, 1); PG8_STAGE(PG8_SA(1, 0), a3, voffA);
            PG8_BAR; PG8_WAIT_L(0); PG8_MMA(1, 0, At, B0); PG8_BAR; PG8_SCHED;
            PG8_STAGE(PG8_SB(1, 1), b3 + hstep, voffB);
            PG8_WAIT_V(6); PG8_BAR; PG8_MMA(1, 1, At, B1); PG8_BAR;
            }
        }
        if constexpr (ALIGN_EPI) { if (wr == 0) PG8_BAR; }
        if constexpr (!Epi::AFTER_DRAIN) { E(acc, cur, wr, wc, fr, fq); S.done(cur); }
        if (!has_next) break;
#pragma unroll
        for (int a = 0; a < 2; ++a)
#pragma unroll
            for (int b = 0; b < 2; ++b)
#pragma unroll
                for (int m = 0; m < 4; ++m)
#pragma unroll
                    for (int n = 0; n < 2; ++n) acc[a][b][m][n] = (f32x4){0.f, 0.f, 0.f, 0.f};
        cur = nxt; cA = nA; cB = nB; ++ui;
        if constexpr (ALIGN_EPI) { if (wr == 1) PG8_BAR; }
    }
    PG8_WAIT_V(0);
    if constexpr (!ALIGN_EPI) { if (wr == 0) PG8_BAR; }
    PG8_BAR;
    if constexpr (Epi::AFTER_DRAIN) { E.fused(acc, cur, wr, wc, fr, fq, lds, wid, lane); S.done(cur); }
#undef PG8_SA
#undef PG8_SB
#undef PG8_STAGE
#undef PG8_LDA
#undef PG8_LDB
#undef PG8_MMA
#undef PG8_WAIT_V
#undef PG8_WAIT_L
#undef PG8_BAR
#undef PG8_SCHED
}
}

DI void p1_epi(const Params& p, int l, const f32x16 (&acc)[2][2], int row0, int cw, int r, int h) {
    unsigned char* ws = p.ws; asm volatile("" : "+s"(ws));
    const int b = row0 >> 13, s0 = row0 & (S_ - 1);
    if (cw < 384) st_rm(acc, (bf16_t*)(ws + O_CQ) + (size_t)row0 * 384 + cw, 384, 1.f, r, h);
    else if (cw < 640) st_rm(acc, (bf16_t*)(ws + O_CKV) + (size_t)row0 * 256 + (cw - 384), 256, 1.f, r, h);
    else if (cw < 2432) {
        int off, part; size_t o_q, o_k, o_vt;
        if (cw < 1408) { off = cw - 640; o_q = O_SBQ; o_k = O_SBK; o_vt = O_SBVT; }
        else if (cw < 2176) { off = cw - 1408; o_q = O_FQ; o_k = O_FK; o_vt = O_FVT; }
        else { off = cw - 2176; o_q = O_MEMQ; o_k = O_MEMQ; o_vt = O_MEMQ; }
        part = off >> 8; const int head = (off & 255) >> 6, bh = b * 4 + head;
        if (part == 0) st_rm(acc, (bf16_t*)(ws + o_q) + ((size_t)bh * S_ + s0) * 64, 64, 0.125f * LOG2E, r, h);
        else if (part == 1) st_rm(acc, (bf16_t*)(ws + o_k) + ((size_t)bh * S_ + s0) * 64, 64, 1.f, r, h);
        else st_tr(acc, (bf16_t*)(ws + o_vt) + (size_t)bh * 64 * S_ + s0, S_, 1.f, r, h);
    } else if (cw < 3456) {
        bf16_t* pb = (bf16_t*)(ws + O_GATE) + (size_t)(row0 + 4 * h) * 1024 + (cw - 2432) + r;
#pragma unroll
        for (int mi = 0; mi < 2; ++mi)
#pragma unroll
            for (int qd = 0; qd < 4; ++qd) {
                bf16_t* q = opaque(pb + (size_t)(32 * mi + 8 * qd) * 1024);
#pragma unroll
                for (int e = 0; e < 4; ++e)
#pragma unroll
                    for (int ni = 0; ni < 2; ++ni) {
                        const float v = acc[mi][ni][4 * qd + e];
                        q[e * 1024 + 32 * ni] = tobf(v * __builtin_amdgcn_rcpf(1.f + fexp2(-v * LOG2E)));
                    }
            }
    } else if (cw < 3584) st_rm(acc, (bf16_t*)(ws + O_MR) + (size_t)row0 * 128 + (cw - 3456), 128, 1.f, r, h);
    else if (cw == 3584) {
        float* pb = (float*)(ws + O_TAIL) + (size_t)(row0 + 4 * h) * 32 + r;
        float* pf = (float*)(ws + O_FL) + (size_t)(b * 4 + (r & 3)) * S_ + s0 + 4 * h;
        const float fb = p.fox_bias[l * 4 + (r & 3)];
#pragma unroll
        for (int mi = 0; mi < 2; ++mi)
#pragma unroll
            for (int qd = 0; qd < 4; ++qd) {
                float* q = opaque(pb + (size_t)(32 * mi + 8 * qd) * 32);
#pragma unroll
                for (int e = 0; e < 4; ++e) q[e * 32] = acc[mi][0][4 * qd + e];
                if (r < 4) {
                    f32x4 o;
#pragma unroll
                    for (int e = 0; e < 4; ++e) { const float xv = acc[mi][1][4 * qd + e] + fb; o[e] = (fminf(xv, 0.f) - log1pf(expf(-fabsf(xv)))) * LOG2E; }
                    *(f32x4*)(pf + 32 * mi + 8 * qd) = o;
                }
            }
    }
}
struct EpiP1 {
    static constexpr bool PERM = true, AFTER_DRAIN = false;
    unsigned char* ws;
    DI void operator()(const pg8::f32x4 (&acc)[2][2][4][2], const pg8::Unit& u, int wr, int wc, int fr, int fq) const {
        const int rowb = u.pm * 256 + wr * 64 + fr, b = (u.pm * 256) >> 13, c8 = 8 * fq;
#pragma unroll
        for (int bj = 0; bj < 2; ++bj) {
            const int cw = u.pn * 256 + bj * 128 + wc * 32;
            if (cw < 640 || cw >= 2432) {
                bf16_t* base; int ld; const bool silu = (cw >= 2432 && cw < 3456);
                if (cw < 384) { base = (bf16_t*)(ws + O_CQ) + cw; ld = 384; }
                else if (cw < 640) { base = (bf16_t*)(ws + O_CKV) + (cw - 384); ld = 256; }
                else if (cw < 3456) { base = (bf16_t*)(ws + O_GATE) + (cw - 2432); ld = 1024; }
                else { base = (bf16_t*)(ws + O_MR) + (cw - 3456); ld = 128; }
                bf16_t* pb = base + (size_t)rowb * ld + c8;
#pragma unroll
                for (int ai = 0; ai < 2; ++ai) {
                    bf16_t* q = opaque(pb + (size_t)(ai * 128) * ld);
#pragma unroll
                    for (int m = 0; m < 4; ++m) {
                        f32x4 v0 = acc[ai][bj][m][0], v1 = acc[ai][bj][m][1];
                        if (silu) {
#pragma unroll
                            for (int e = 0; e < 4; ++e) { v0[e] = v0[e] * __builtin_amdgcn_rcpf(1.f + fexp2(-v0[e] * LOG2E)); v1[e] = v1[e] * __builtin_amdgcn_rcpf(1.f + fexp2(-v1[e] * LOG2E)); }
                        }
                        u32x4 wv; wv.x = pk2(v0.x, v0.y); wv.y = pk2(v0.z, v0.w); wv.z = pk2(v1.x, v1.y); wv.w = pk2(v1.z, v1.w);
                        *(u32x4*)(q + (size_t)(m * 16) * ld) = wv;
                    }
                }
            } else {
                int off; size_t o_q, o_k, o_vt;
                if (cw < 1408) { off = cw - 640; o_q = O_SBQ; o_k = O_SBK; o_vt = O_SBVT; }
                else if (cw < 2176) { off = cw - 1408; o_q = O_FQ; o_k = O_FK; o_vt = O_FVT; }
                else { off = cw - 2176; o_q = O_MEMQ; o_k = O_MEMQ; o_vt = O_MEMQ; }
                const int part = off >> 8, head = (off & 255) >> 6, d0 = (off & 63) + c8, bh = b * 4 + head;
                const int s0 = rowb & (S_ - 1);
                if (part < 2) {
                    const float sc = part == 0 ? 0.125f * LOG2E : 1.f;
                    bf16_t* pb = (bf16_t*)(ws + (part == 0 ? o_q : o_k)) + ((size_t)bh * S_ + s0) * 64 + d0;
#pragma unroll
                    for (int ai = 0; ai < 2; ++ai) {
                        bf16_t* q = opaque(pb + (size_t)(ai * 128) * 64);
#pragma unroll
                        for (int m = 0; m < 4; ++m) {
                            const f32x4 v0 = acc[ai][bj][m][0] * sc, v1 = acc[ai][bj][m][1] * sc;
                            u32x4 wv; wv.x = pk2(v0.x, v0.y); wv.y = pk2(v0.z, v0.w); wv.z = pk2(v1.x, v1.y); wv.w = pk2(v1.z, v1.w);
                            *(u32x4*)(q + (m * 16) * 64) = wv;
                        }
                    }
                } else {
                    bf16_t* pb = (bf16_t*)(ws + o_vt) + ((size_t)bh * 64 + d0) * S_ + s0;
#pragma unroll
                    for (int ai = 0; ai < 2; ++ai)
#pragma unroll
                        for (int m = 0; m < 4; ++m) {
                            bf16_t* q = opaque(pb + ai * 128 + m * 16);
                            const f32x4 v0 = acc[ai][bj][m][0], v1 = acc[ai][bj][m][1];
                            q[0] = tobf(v0.x); q[(size_t)S_] = tobf(v0.y); q[(size_t)2 * S_] = tobf(v0.z); q[(size_t)3 * S_] = tobf(v0.w);
                            q[(size_t)4 * S_] = tobf(v1.x); q[(size_t)5 * S_] = tobf(v1.y); q[(size_t)6 * S_] = tobf(v1.z); q[(size_t)7 * S_] = tobf(v1.w);
                        }
                }
            }
        }
    }
};
DI void phase1(const Params& p, int l, unsigned char* smem) {
    unsigned char* ws = p.ws; asm volatile("" : "+s"(ws));
    const bf16_t* XB = (const bf16_t*)(ws + O_XB);
    const bf16_t* W = (const bf16_t*)(ws + O_WIN + l * SZ_WIN);
    {
        pg8::Gemm g; g.A = XB; g.Bt = W; g.M = T_; g.N = 3584; g.K = 1024;
        pg8::StaticOrder S; S.init(T_, 3584, (int)gridDim.x, (int)blockIdx.x);
        EpiP1 E; E.ws = ws;
        pg8::gemm_phase<EpiP1, pg8::StaticOrder, true, true>((PG8_LAS unsigned char*)smem, g, S, E);
    }
    {
        unsigned char* hs = smem + vhalf() * HALF_SMEM;
        const int t4 = tid_op(), lane4 = t4 & 63, w4 = t4 >> 6, wr4 = w4 >> 1, wc4 = w4 & 1, r4 = lane4 & 31, h4 = lane4 >> 5;
        for (int t = VB; t < 256; t += VG) {
            const int m0 = t * 128;
            f32x16 acc[2];
#pragma unroll
            for (int i = 0; i < 16; ++i) { acc[0][i] = 0.f; acc[1][i] = 0.f; }
            gemm_accum_n1(acc, XB + (size_t)m0 * 1024, 1024, W + (size_t)3584 * 1024, 1024, 16, hs);
            const int row0 = m0 + 64 * wr4, b = row0 >> 13, s0 = row0 & (S_ - 1);
            if (wc4 == 0) {
                float* pb = (float*)(ws + O_TAIL) + (size_t)(row0 + 4 * h4) * 32 + r4;
#pragma unroll
                for (int mi = 0; mi < 2; ++mi)
#pragma unroll
                    for (int qd = 0; qd < 4; ++qd) {
                        float* q = opaque(pb + (size_t)(32 * mi + 8 * qd) * 32);
#pragma unroll
                        for (int e = 0; e < 4; ++e) q[e * 32] = acc[mi][4 * qd + e];
                    }
            } else if (r4 < 4) {
                float* pf = (float*)(ws + O_FL) + (size_t)(b * 4 + r4) * S_ + s0 + 4 * h4;
                const float fb = p.fox_bias[l * 4 + r4];
#pragma unroll
                for (int mi = 0; mi < 2; ++mi)
#pragma unroll
                    for (int qd = 0; qd < 4; ++qd) {
                        f32x4 o;
#pragma unroll
                        for (int e = 0; e < 4; ++e) { const float xv = acc[mi][4 * qd + e] + fb; o[e] = (fminf(xv, 0.f) - log1pf(expf(-fabsf(xv)))) * LOG2E; }
                        *(f32x4*)(pf + 32 * mi + 8 * qd) = o;
                    }
            }
        }
        for (int t = VB - 256; t >= 0 && t < 32; t += VG) {
            const int m0 = (t >> 2) * 128, n0 = (t & 3) * 128;
            f32x16 acc[2][2]; zero4(acc);
            gemm_accum(acc, (const bf16_t*)(ws + O_MEMB) + (size_t)m0 * 1024, 1024, (const bf16_t*)(ws + O_WMEM + l * SZ_WMEM) + (size_t)n0 * 1024, 1024, 16, hs);
            const int row0 = m0 + 64 * wr4, b = row0 >> 8, j0 = row0 & 255, gc = n0 + 64 * wc4;
            if (gc < 256) st_rm(acc, (bf16_t*)(ws + O_MEMK) + ((size_t)(b * 4 + (gc >> 6)) * 256 + j0) * 64, 64, 1.f, r4, h4);
            else st_tr(acc, (bf16_t*)(ws + O_MEMVT) + (size_t)(b * 4 + ((gc - 256) >> 6)) * 64 * 256 + j0, 256, 1.f, r4, h4);
        }
    }
}

template <int K> DI void row_rstd(const bf16_t* A, float* rs) {
    const int tid = tid_op(), row = tid >> 1, half = tid & 1;
    constexpr int n = K / 2;
    const bf16_t* pr = A + (size_t)row * K + half * n;
    u32x4 v[n / 8];
#pragma unroll
    for (int j = 0; j < n / 8; ++j) v[j] = *(const u32x4*)(pr + 8 * j);
    float s = 0.f;
#pragma unroll
    for (int j = 0; j < n / 8; ++j) {
        float a;
        a = bflo(v[j].x); s += a * a; a = bfhi(v[j].x); s += a * a; a = bflo(v[j].y); s += a * a; a = bfhi(v[j].y); s += a * a;
        a = bflo(v[j].z); s += a * a; a = bfhi(v[j].z); s += a * a; a = bflo(v[j].w); s += a * a; a = bfhi(v[j].w); s += a * a;
    }
    s += __shfl_xor(s, 1);
    if (half == 0) rs[row] = rsqrtf(s / (float)K + 1e-6f);
}
template <int K> DI void row_rstd8(const bf16_t* A, float* rs) {
    const int tid = tid8_op(), row = tid >> 1, half = tid & 1;
    constexpr int n = K / 2;
    const bf16_t* pr = A + (size_t)row * K + half * n;
    float s = 0.f;
#pragma unroll 1
    for (int c = 0; c < n / 64; ++c) {
        u32x4 v[8];
#pragma unroll
        for (int j = 0; j < 8; ++j) v[j] = *(const u32x4*)(pr + 64 * c + 8 * j);
#pragma unroll
        for (int j = 0; j < 8; ++j) {
            float a;
            a = bflo(v[j].x); s += a * a; a = bfhi(v[j].x); s += a * a; a = bflo(v[j].y); s += a * a; a = bfhi(v[j].y); s += a * a;
            a = bflo(v[j].z); s += a * a; a = bfhi(v[j].z); s += a * a; a = bflo(v[j].w); s += a * a; a = bfhi(v[j].w); s += a * a;
        }
    }
    s += __shfl_xor(s, 1);
    if (half == 0) rs[row] = rsqrtf(s / (float)K + 1e-6f);
}
struct EpiQ {
    static constexpr bool PERM = true, AFTER_DRAIN = false;
    unsigned char* ws; const float* rs;
    DI void operator()(const pg8::f32x4 (&acc)[2][2][4][2], const pg8::Unit& u, int wr, int wc, int fr, int fq) const {
        asm volatile("" : "+v"(fr), "+v"(fq));
        const int rowb = u.pm * 256 + wr * 64 + fr, b = (u.pm * 256) >> 13, s0 = rowb & (S_ - 1), hh = fq >> 1;
        const float qs = 0.10206207261596575f * LOG2E;
        const float* COS = (const float*)(ws + O_COS); const float* SIN = (const float*)(ws + O_SIN);
#pragma unroll
        for (int bj = 0; bj < 2; ++bj) {
            const int c0 = u.pn * 256 + bj * 128 + wc * 32;
            if (c0 < 384) {
                const int head = c0 / 96, d0 = c0 - head * 96;
                bf16_t* pb = (bf16_t*)(ws + O_MQ) + ((size_t)(b * 4 + head) * S_ + s0) * 96 + d0 + 8 * fq;
#pragma unroll
                for (int ai = 0; ai < 2; ++ai)
#pragma unroll
                    for (int m = 0; m < 4; ++m) {
                        const int rl = ai * 128 + wr * 64 + m * 16 + fr;
                        const float sc = rs[rl] * qs;
                        f32x4 v0 = acc[ai][bj][m][0] * sc, v1 = acc[ai][bj][m][1] * sc;
                        if (d0 == 64) {
                            const float* pc = opaque(COS + (size_t)(rowb + ai * 128 + m * 16) * 16 + 8 * (fq & 1));
                            const float* ps = SIN + (pc - COS);
                            {   const f32x4 cv = *(const f32x4*)pc, sv = *(const f32x4*)ps; f32x4 pp;
#pragma unroll
                                for (int e = 0; e < 4; ++e) pp[e] = xhalf_other(v0[e], hh);
                                v0 = hh ? (v0 * cv + pp * sv) : (v0 * cv - pp * sv); }
                            {   const f32x4 cv = *(const f32x4*)(pc + 4), sv = *(const f32x4*)(ps + 4); f32x4 pp;
#pragma unroll
                                for (int e = 0; e < 4; ++e) pp[e] = xhalf_other(v1[e], hh);
                                v1 = hh ? (v1 * cv + pp * sv) : (v1 * cv - pp * sv); }
                        }
                        u32x4 wv; wv.x = pk2(v0.x, v0.y); wv.y = pk2(v0.z, v0.w); wv.z = pk2(v1.x, v1.y); wv.w = pk2(v1.z, v1.w);
                        *(u32x4*)(opaque(pb) + (size_t)(ai * 128 + m * 16) * 96) = wv;
                        asm volatile("" ::: "memory");
                    }
            }
        }
    }
};
struct EpiKV {
    static constexpr bool PERM = true, AFTER_DRAIN = false;
    unsigned char* ws; const float* rs;
    DI void operator()(const pg8::f32x4 (&acc)[2][2][4][2], const pg8::Unit& u, int wr, int wc, int fr, int fq) const {
        asm volatile("" : "+v"(fr), "+v"(fq));
        const int rowb = u.pm * 256 + wr * 64 + fr, b = (u.pm * 256) >> 13, s0 = rowb & (S_ - 1);
#pragma unroll
        for (int bj = 0; bj < 2; ++bj) {
            const int c0 = u.pn * 256 + bj * 128 + wc * 32, bh = b * 4 + (c0 >> 7), within = c0 & 127;
            if (within < 64) {
                bf16_t* pb = (bf16_t*)(ws + O_MK) + ((size_t)bh * S_ + s0) * 96 + within + 8 * fq;
#pragma unroll
                for (int ai = 0; ai < 2; ++ai)
#pragma unroll
                    for (int m = 0; m < 4; ++m) {
                        const float sc = rs[ai * 128 + wr * 64 + m * 16 + fr];
                        const f32x4 v0 = acc[ai][bj][m][0] * sc, v1 = acc[ai][bj][m][1] * sc;
                        u32x4 wv; wv.x = pk2(v0.x, v0.y); wv.y = pk2(v0.z, v0.w); wv.z = pk2(v1.x, v1.y); wv.w = pk2(v1.z, v1.w);
                        *(u32x4*)(opaque(pb) + (size_t)(ai * 128 + m * 16) * 96) = wv;
                        asm volatile("" ::: "memory");
                    }
            } else {
                bf16_t* pb = (bf16_t*)(ws + O_MVT) + ((size_t)bh * 64 + (within - 64) + 8 * fq) * S_ + s0;
#pragma unroll
                for (int ai = 0; ai < 2; ++ai)
#pragma unroll
                    for (int m = 0; m < 4; ++m) {
                        const float sc = rs[ai * 128 + wr * 64 + m * 16 + fr];
                        const f32x4 v0 = acc[ai][bj][m][0] * sc, v1 = acc[ai][bj][m][1] * sc;
                        bf16_t* q = opaque(pb + ai * 128 + m * 16);
                        q[0] = tobf(v0.x); q[(size_t)S_] = tobf(v0.y); q[(size_t)2 * S_] = tobf(v0.z); q[(size_t)3 * S_] = tobf(v0.w);
                        q[(size_t)4 * S_] = tobf(v1.x); q[(size_t)5 * S_] = tobf(v1.y); q[(size_t)6 * S_] = tobf(v1.z); q[(size_t)7 * S_] = tobf(v1.w);
                    }
            }
        }
    }
};
struct OneUnit {
    pg8::Unit u;
    __device__ __forceinline__ bool next(int i, pg8::Unit& o) const { if (i != 0) return false; o = u; return true; }
    __device__ __forceinline__ void a_ready(const pg8::Unit&) const {}
    __device__ __forceinline__ void done(const pg8::Unit&) const {}
};
DI void phase2_gemms(const Params& p, int l, unsigned char* smem0) {
    unsigned char* ws = p.ws; asm volatile("" : "+s"(ws));
    pg8::StaticOrder S; S.init(T_, 512, (int)gridDim.x, (int)blockIdx.x);
    float* rsq = (float*)(smem0 + 131072); float* rskv = rsq + 256;
    OneUnit O;
#pragma unroll 1
    for (int i = 0; S.next(i, O.u); ++i) {
        row_rstd8<384>((const bf16_t*)(ws + O_CQ) + (size_t)O.u.pm * 256 * 384, rsq);
        row_rstd8<256>((const bf16_t*)(ws + O_CKV) + (size_t)O.u.pm * 256 * 256, rskv);
        __syncthreads();
        { pg8::Gemm g; g.A = (const bf16_t*)(ws + O_CQ); g.Bt = (const bf16_t*)(ws + O_WQB + l * SZ_WQB); g.M = T_; g.N = 512; { int kk = 384; asm volatile("" : "+s"(kk)); g.K = kk; }
          EpiQ E; E.ws = ws; E.rs = rsq; pg8::gemm_phase<EpiQ, OneUnit, true, true>((PG8_LAS unsigned char*)smem0, g, O, E); }
        { pg8::Gemm g; g.A = (const bf16_t*)(ws + O_CKV); g.Bt = (const bf16_t*)(ws + O_WKVB + l * SZ_WKVB); g.M = T_; g.N = 512; { int kk = 256; asm volatile("" : "+s"(kk)); g.K = kk; }
          EpiKV E; E.ws = ws; E.rs = rskv; pg8::gemm_phase<EpiKV, OneUnit, true, true>((PG8_LAS unsigned char*)smem0, g, O, E); }
        __syncthreads();
    }
}
DI void phase2(const Params& p, int l, unsigned char* smem) {
    unsigned char* ws = p.ws; asm volatile("" : "+s"(ws));
    const int tid = tid_op(), lane = tid & 63, w = tid >> 6, wr = w >> 1, wc = w & 1, r = lane & 31, h = lane >> 5;
    float* rs = (float*)(smem + SMEM_RS);
    const float* COS = (const float*)(ws + O_COS); const float* SIN = (const float*)(ws + O_SIN);
    for (int nn = VB; nn < 272; nn += VG) {
        const int it = nn < 16 ? nn : (nn < 144 ? 1840 + (nn - 16) : 1968 + (nn - 144));
        __syncthreads();
        if (it >= 1968) {
            const int bh = (it - 1968) >> 3, ch = (it - 1968) & 7;
            const bf16_t* kp = (const bf16_t*)(ws + O_FK) + ((size_t)bh * S_ + ch * 1024 + tid * 4) * 64;
            u32x4 v[4][8];
#pragma unroll
            for (int j = 0; j < 4; ++j)
#pragma unroll
                for (int c = 0; c < 8; ++c) v[j][c] = *(const u32x4*)(kp + j * 64 + 8 * c);
            float mxn = 0.f;
#pragma unroll
            for (int j = 0; j < 4; ++j) {
                float q = 0.f;
#pragma unroll
                for (int c = 0; c < 8; ++c) { float a; a = bflo(v[j][c].x); q += a * a; a = bfhi(v[j][c].x); q += a * a; a = bflo(v[j][c].y); q += a * a; a = bfhi(v[j][c].y); q += a * a;
                    a = bflo(v[j][c].z); q += a * a; a = bfhi(v[j][c].z); q += a * a; a = bflo(v[j][c].w); q += a * a; a = bfhi(v[j][c].w); q += a * a; }
                mxn = fmaxf(mxn, q);
            }
#pragma unroll
            for (int d = 32; d >= 1; d >>= 1) mxn = fmaxf(mxn, __shfl_xor(mxn, d));
            if (lane == 0) atomicMax((unsigned*)(ws + O_KMAX) + bh, __float_as_uint(mxn));
        } else if (it < 16) {
            const float* fl = (const float*)(ws + O_FL) + (size_t)it * S_ + tid * 32;
            f32x4 v[8];
#pragma unroll
            for (int j = 0; j < 8; ++j) v[j] = *(const f32x4*)(fl + 4 * j);
            float sum = 0.f;
#pragma unroll
            for (int j = 0; j < 8; ++j) { sum += v[j].x; v[j].x = sum; sum += v[j].y; v[j].y = sum; sum += v[j].z; v[j].z = sum; sum += v[j].w; v[j].w = sum; }
            float inc = sum;
#pragma unroll
            for (int d = 1; d < 64; d <<= 1) { const float o = __shfl_up(inc, d); if (lane >= d) inc += o; }
            float* wt = (float*)smem;
            if (lane == 63) wt[w] = inc;
            __syncthreads();
            float pre = inc - sum;
            for (int k = 0; k < w; ++k) pre += wt[k];
            float* fc = (float*)(ws + O_FC) + (size_t)it * S_ + tid * 32;
#pragma unroll
            for (int j = 0; j < 8; ++j) *(f32x4*)(fc + 4 * j) = -(v[j] + pre);
        } else {
            const int tk = (it - 1840) * 256 + tid, b = tk >> 13, s = tk & (S_ - 1);
            const float* tl = (const float*)(ws + O_TAIL) + (size_t)tk * 32;
            float x1[16], x2[16], c[16], sn[16];
#pragma unroll
            for (int j = 0; j < 4; ++j) {
                const f32x4 a = *(const f32x4*)(tl + 4 * j), bb = *(const f32x4*)(tl + 16 + 4 * j);
                const f32x4 cc = *(const f32x4*)(COS + (size_t)tk * 16 + 4 * j), ss = *(const f32x4*)(SIN + (size_t)tk * 16 + 4 * j);
                x1[4 * j] = a.x; x1[4 * j + 1] = a.y; x1[4 * j + 2] = a.z; x1[4 * j + 3] = a.w;
                x2[4 * j] = bb.x; x2[4 * j + 1] = bb.y; x2[4 * j + 2] = bb.z; x2[4 * j + 3] = bb.w;
                c[4 * j] = cc.x; c[4 * j + 1] = cc.y; c[4 * j + 2] = cc.z; c[4 * j + 3] = cc.w;
                sn[4 * j] = ss.x; sn[4 * j + 1] = ss.y; sn[4 * j + 2] = ss.z; sn[4 * j + 3] = ss.w;
            }
            u32x4 o[4];
#pragma unroll
            for (int j = 0; j < 2; ++j) {
                u32x4 a, bb;
                a.x = pk2(x1[8 * j] * c[8 * j] - x2[8 * j] * sn[8 * j], x1[8 * j + 1] * c[8 * j + 1] - x2[8 * j + 1] * sn[8 * j + 1]);
                a.y = pk2(x1[8 * j + 2] * c[8 * j + 2] - x2[8 * j + 2] * sn[8 * j + 2], x1[8 * j + 3] * c[8 * j + 3] - x2[8 * j + 3] * sn[8 * j + 3]);
                a.z = pk2(x1[8 * j + 4] * c[8 * j + 4] - x2[8 * j + 4] * sn[8 * j + 4], x1[8 * j + 5] * c[8 * j + 5] - x2[8 * j + 5] * sn[8 * j + 5]);
                a.w = pk2(x1[8 * j + 6] * c[8 * j + 6] - x2[8 * j + 6] * sn[8 * j + 6], x1[8 * j + 7] * c[8 * j + 7] - x2[8 * j + 7] * sn[8 * j + 7]);
                bb.x = pk2(x1[8 * j] * sn[8 * j] + x2[8 * j] * c[8 * j], x1[8 * j + 1] * sn[8 * j + 1] + x2[8 * j + 1] * c[8 * j + 1]);
                bb.y = pk2(x1[8 * j + 2] * sn[8 * j + 2] + x2[8 * j + 2] * c[8 * j + 2], x1[8 * j + 3] * sn[8 * j + 3] + x2[8 * j + 3] * c[8 * j + 3]);
                bb.z = pk2(x1[8 * j + 4] * sn[8 * j + 4] + x2[8 * j + 4] * c[8 * j + 4], x1[8 * j + 5] * sn[8 * j + 5] + x2[8 * j + 5] * c[8 * j + 5]);
                bb.w = pk2(x1[8 * j + 6] * sn[8 * j + 6] + x2[8 * j + 6] * c[8 * j + 6], x1[8 * j + 7] * sn[8 * j + 7] + x2[8 * j + 7] * c[8 * j + 7]);
                o[j] = a; o[2 + j] = bb;
            }
#pragma unroll
            for (int hh = 0; hh < 4; ++hh) {
                bf16_t* d = (bf16_t*)(ws + O_MK) + ((size_t)(b * 4 + hh) * S_ + s) * 96 + 64;
                *(u32x4*)d = o[0]; *(u32x4*)(d + 8) = o[1]; *(u32x4*)(d + 16) = o[2]; *(u32x4*)(d + 24) = o[3];
            }
        }
    }
}

constexpr int ATT_BUF = 22784;
template <int DQK, int MODE, bool DESC>
DI void attn_item(const bf16_t* Q, const bf16_t* K, const bf16_t* VT, int ldv, const float* cdec, int q0, int ntiles, const bf16_t* gt, bf16_t* yb, unsigned char* smem, unsigned char* smem0, int hf, float kmax = 0.f) {
    constexpr int KS = DQK + 8, NKS = DQK / 16, KCH = DQK / 8, NKL = 64 * KCH / 256;
    const int tid = tid_op(), lane = tid & 63, w = tid >> 6, r = lane & 31, h = lane >> 5;
    const int qidx = q0 + 32 * w + r;
    bf16x8 qf[NKS];
#pragma unroll
    for (int s = 0; s < NKS; ++s) qf[s] = *(const bf16x8*)(Q + (size_t)(32 * w + r) * DQK + 16 * s + 8 * h);
    float qn = 0.f;
    if (MODE == 0 && DESC) {
#pragma unroll
        for (int s = 0; s < NKS; ++s)
#pragma unroll
            for (int j = 0; j < 8; ++j) { const float a = __uint_as_float(((unsigned)(unsigned short)qf[s][j]) << 16); qn += a * a; }
        qn += xhalf_other(qn, h);
        qn = sqrtf(qn) * kmax;
    }
    f32x16 o0, o1;
#pragma unroll
    for (int i = 0; i < 16; ++i) { o0[i] = 0.f; o1[i] = 0.f; }
    float m = -INFINITY, lsum = 0.f, R = 1.f;
    u32x4 rk[NKL], rv[2]; f32x4 rc = {0.f, 0.f, 0.f, 0.f};
    const unsigned okk = (unsigned)(((tid / KCH) * DQK + (tid % KCH) * 8) * 2);
    const unsigned ovv = (unsigned)(((tid >> 3) * ldv + (tid & 7) * 8) * 2), svv = (unsigned)(ldv * 64);
    auto ld_tile = [&](int kt) {
        const unsigned char* Kt = (const unsigned char*)(K + (size_t)(64 * kt) * DQK);
        const unsigned char* Vt = (const unsigned char*)(VT + 64 * kt);
#pragma unroll
        for (int j = 0; j < NKL; ++j) rk[j] = *(const u32x4*)(Kt + (okk + j * 4096));
#pragma unroll
        for (int j = 0; j < 2; ++j) rv[j] = *(const u32x4*)(Vt + (ovv + j * svv));
        if (cdec && tid < 16) rc = *(const f32x4*)(cdec + 64 * kt + 4 * tid);
    };
    auto st_tile = [&](int buf) {
        bf16_t* sK = (bf16_t*)(smem + buf * ATT_BUF); bf16_t* sV = (bf16_t*)(smem + buf * ATT_BUF + 13312); float* sC = (float*)(smem + buf * ATT_BUF + 22528);
#pragma unroll
        for (int j = 0; j < NKL; ++j) { const int c = tid + 256 * j, row = c / KCH, kc = (c % KCH) * 8; *(u32x4*)(sK + row * KS + kc) = rk[j]; }
#pragma unroll
        for (int j = 0; j < 2; ++j) { const int c = tid + 256 * j, row = c >> 3, kc = (c & 7) * 8; *(u32x4*)(sV + row * LS + kc) = rv[j]; }
        if (cdec && tid < 16) *(f32x4*)(sC + 4 * tid) = rc;
    };
    ld_tile(DESC ? ntiles - 1 : 0);
    __syncthreads();
    st_tile(0);
#pragma unroll 1
    for (int it = 0; it < ntiles; ++it) {
        const int kt = DESC ? ntiles - 1 - it : it, buf = it & 1;
        if (it + 1 < ntiles) ld_tile(DESC ? kt - 1 : kt + 1);
        __syncthreads();
        if ((MODE == 1 || (MODE == 0 && DESC)) && it > 0) {
            const int* fl = (const int*)(smem0 + SMEM_FLAG) + ((it - 1) & 1) * 8;
            if ((fl[0] & fl[1] & fl[2] & fl[3] & fl[4] & fl[5] & fl[6] & fl[7]) != 0) break;
        }
        const bf16_t* sK = (const bf16_t*)(smem + buf * ATT_BUF); const bf16_t* sV = (const bf16_t*)(smem + buf * ATT_BUF + 13312);
        const float* sC = (const float*)(smem + buf * ATT_BUF + 22528);
        bool active = true;
        if (MODE == 0) active = (64 * kt <= q0 + 32 * w + 31);
        if (MODE == 1) active = (64 * kt < q0 + 32 * w + 31);
        if (active) {
            f32x16 sc[2];
#pragma unroll
            for (int i = 0; i < 16; ++i) { sc[0][i] = 0.f; sc[1][i] = 0.f; }
#pragma unroll
            for (int s = 0; s < NKS; ++s) {
                const bf16x8 k0 = *(const bf16x8*)(sK + r * KS + 16 * s + 8 * h), k1 = *(const bf16x8*)(sK + (32 + r) * KS + 16 * s + 8 * h);
                sc[0] = MFMA32(k0, qf[s], sc[0]);
                sc[1] = MFMA32(k1, qf[s], sc[1]);
            }
            bf16x8 pf[4];
            if (MODE == 1) {
                float u[2][16];
#pragma unroll
                for (int mt = 0; mt < 2; ++mt)
#pragma unroll
                    for (int i = 0; i < 16; ++i) sc[mt][i] = __builtin_amdgcn_rcpf(1.f + fexp2(-sc[mt][i]));
                if (64 * kt + 63 >= q0 + 32 * w) {
#pragma unroll
                    for (int mt = 0; mt < 2; ++mt)
#pragma unroll
                        for (int i = 0; i < 16; ++i)
                            if (!(64 * kt + 32 * mt + crow(i, h) < qidx)) sc[mt][i] = 0.f;
                }
#pragma unroll
                for (int mt = 0; mt < 2; ++mt)
#pragma unroll
                    for (int i = 0; i < 16; ++i) u[mt][i] = 1.f - sc[mt][i];
                float p23[2][4], gs[2][4], go[2][4];
#pragma unroll
                for (int mt = 0; mt < 2; ++mt)
#pragma unroll
                    for (int qd = 0; qd < 4; ++qd) {
                        p23[mt][qd] = u[mt][4 * qd + 2] * u[mt][4 * qd + 3];
                        gs[mt][qd] = (u[mt][4 * qd] * u[mt][4 * qd + 1]) * p23[mt][qd];
                        go[mt][qd] = xhalf_other(gs[mt][qd], h);
                    }
                float run = R;
#pragma unroll
                for (int mt = 1; mt >= 0; --mt)
#pragma unroll
                    for (int qd = 3; qd >= 0; --qd) {
                        const float ex = h ? run : run * go[mt][qd];
                        run *= gs[mt][qd] * go[mt][qd];
                        const float e2 = ex * u[mt][4 * qd + 3], e1 = ex * p23[mt][qd], e0 = e1 * u[mt][4 * qd + 1];
                        sc[mt][4 * qd + 3] *= ex; sc[mt][4 * qd + 2] *= e2; sc[mt][4 * qd + 1] *= e1; sc[mt][4 * qd] *= e0;
                    }
                R = run;
            } else {
                f32x4 s4[2][4];
#pragma unroll
                for (int mt = 0; mt < 2; ++mt) {
                    s4[mt][0] = __builtin_shufflevector(sc[mt], sc[mt], 0, 1, 2, 3);
                    s4[mt][1] = __builtin_shufflevector(sc[mt], sc[mt], 4, 5, 6, 7);
                    s4[mt][2] = __builtin_shufflevector(sc[mt], sc[mt], 8, 9, 10, 11);
                    s4[mt][3] = __builtin_shufflevector(sc[mt], sc[mt], 12, 13, 14, 15);
                }
                if (cdec) {
#pragma unroll
                    for (int mt = 0; mt < 2; ++mt)
#pragma unroll
                        for (int qd = 0; qd < 4; ++qd) s4[mt][qd] += *(const f32x4*)(sC + 32 * mt + 8 * qd + 4 * h);
                }
                if (MODE == 0 && (64 * kt + 63 > q0 + 32 * w)) {
#pragma unroll
                    for (int mt = 0; mt < 2; ++mt)
#pragma unroll
                        for (int qd = 0; qd < 4; ++qd)
#pragma unroll
                            for (int e = 0; e < 4; ++e)
                                if (64 * kt + 32 * mt + 8 * qd + 4 * h + e > qidx) s4[mt][qd][e] = -INFINITY;
                }
                float mx = fmaxf(s4[0][0].x, s4[1][0].x);
#pragma unroll
                for (int qd = 0; qd < 4; ++qd) {
                    mx = fmaxf(fmaxf(mx, s4[0][qd].y), s4[1][qd].y);
                    mx = fmaxf(fmaxf(mx, s4[0][qd].z), s4[1][qd].z);
                    mx = fmaxf(fmaxf(mx, s4[0][qd].w), s4[1][qd].w);
                    if (qd < 3) mx = fmaxf(fmaxf(mx, s4[0][qd + 1].x), s4[1][qd + 1].x);
                }
                mx = xhalf_max(mx);
                const float mn = fmaxf(m, mx), alpha = fexp2(m - mn);
                m = mn;
                f32x4 ps4 = {0.f, 0.f, 0.f, 0.f};
                const float nmn = -mn;
                const f32x4 nm4 = {nmn, nmn, nmn, nmn};
                if (__builtin_amdgcn_ballot_w64(alpha != 1.f) != 0) { o0 *= alpha; o1 *= alpha; }
#pragma unroll
                for (int s2 = 0; s2 < 4; ++s2) {
                    const int mt = s2 >> 1, s = s2 & 1;
                    f32x4 da = s4[mt][2 * s] + nm4, db = s4[mt][2 * s + 1] + nm4;
                    da.x = fexp2(da.x); da.y = fexp2(da.y); da.z = fexp2(da.z); da.w = fexp2(da.w);
                    db.x = fexp2(db.x); db.y = fexp2(db.y); db.z = fexp2(db.z); db.w = fexp2(db.w);
                    ps4 += da; ps4 += db;
                    u32x4 pp;
                    pp.x = pk2(da.x, da.y); pp.y = pk2(da.z, da.w); pp.z = pk2(db.x, db.y); pp.w = pk2(db.z, db.w);
                    const bf16x8 pfr = __builtin_bit_cast(bf16x8, pp);
                    const s16x4 a0 = *(const s16x4*)(sV + r * LS + 16 * s2 + 4 * h), a1 = *(const s16x4*)(sV + r * LS + 16 * s2 + 8 + 4 * h);
                    const s16x4 b0 = *(const s16x4*)(sV + (32 + r) * LS + 16 * s2 + 4 * h), b1 = *(const s16x4*)(sV + (32 + r) * LS + 16 * s2 + 8 + 4 * h);
                    const bf16x8 v0 = __builtin_shufflevector(a0, a1, 0, 1, 2, 3, 4, 5, 6, 7), v1 = __builtin_shufflevector(b0, b1, 0, 1, 2, 3, 4, 5, 6, 7);
                    o0 = MFMA32(v0, pfr, o0);
                    o1 = MFMA32(v1, pfr, o1);
                }
                lsum = lsum * alpha + ((ps4.x + ps4.y) + (ps4.z + ps4.w));
            }
            if (MODE == 1) {
#pragma unroll
            for (int mt = 0; mt < 2; ++mt)
#pragma unroll
                for (int s = 0; s < 2; ++s) {
                    u32x4 pp;
                    pp.x = pk2(sc[mt][8 * s], sc[mt][8 * s + 1]); pp.y = pk2(sc[mt][8 * s + 2], sc[mt][8 * s + 3]);
                    pp.z = pk2(sc[mt][8 * s + 4], sc[mt][8 * s + 5]); pp.w = pk2(sc[mt][8 * s + 6], sc[mt][8 * s + 7]);
                    pf[2 * mt + s] = __builtin_bit_cast(bf16x8, pp);
                }
#pragma unroll
            for (int s2 = 0; s2 < 4; ++s2) {
                const s16x4 a0 = *(const s16x4*)(sV + r * LS + 16 * s2 + 4 * h), a1 = *(const s16x4*)(sV + r * LS + 16 * s2 + 8 + 4 * h);
                const s16x4 b0 = *(const s16x4*)(sV + (32 + r) * LS + 16 * s2 + 4 * h), b1 = *(const s16x4*)(sV + (32 + r) * LS + 16 * s2 + 8 + 4 * h);
                const bf16x8 v0 = __builtin_shufflevector(a0, a1, 0, 1, 2, 3, 4, 5, 6, 7), v1 = __builtin_shufflevector(b0, b1, 0, 1, 2, 3, 4, 5, 6, 7);
                o0 = MFMA32(v0, pf[s2], o0);
                o1 = MFMA32(v1, pf[s2], o1);
            }
            }
        }
        if (MODE == 1) {
            const int done = (__builtin_amdgcn_ballot_w64(R != 0.f) == 0) ? 1 : 0;
            if (lane == 0) ((int*)(smem0 + SMEM_FLAG))[(it & 1) * 8 + hf * 4 + w] = done;
        }
        if (MODE == 0 && DESC) {
            const float ncl = (kt > 0) ? cdec[64 * kt - 1] : 0.f;
            const bool live = !(qn + ncl - m < -152.f);
            const int done = (__builtin_amdgcn_ballot_w64(live) == 0) ? 1 : 0;
            if (lane == 0) ((int*)(smem0 + SMEM_FLAG))[(it & 1) * 8 + hf * 4 + w] = done;
        }
        if (it + 1 < ntiles) st_tile(buf ^ 1);
    }
    if (MODE != 1) {
        const float lt = lsum + xhalf_other(lsum, h), inv = __builtin_amdgcn_rcpf(lt);
        o0 *= inv; o1 *= inv;
    }
    bf16_t* yrow = yb + (size_t)(32 * w + r) * 1024 + 4 * h;
    const bf16_t* grow = gt + (size_t)(32 * w + r) * 1024 + 4 * h;
    u32x2 gv[2][4];
#pragma unroll
    for (int nt = 0; nt < 2; ++nt)
#pragma unroll
        for (int qd = 0; qd < 4; ++qd) gv[nt][qd] = *(const u32x2*)(grow + 32 * nt + 8 * qd);
#pragma unroll
    for (int nt = 0; nt < 2; ++nt)
#pragma unroll
        for (int qd = 0; qd < 4; ++qd) {
            const u32x2 g = gv[nt][qd];
            const f32x16& o = nt ? o1 : o0;
            u32x2 v;
            v.x = pk2(o[4 * qd] * bflo(g.x), o[4 * qd + 1] * bfhi(g.x));
            v.y = pk2(o[4 * qd + 2] * bflo(g.y), o[4 * qd + 3] * bfhi(g.y));
            *(u32x2*)(yrow + 32 * nt + 8 * qd) = v;
        }
}
DI void phase3(const Params& p, int l, unsigned char* smem, unsigned char* smem0) {
    unsigned char* ws = p.ws; asm volatile("" : "+s"(ws));
    unsigned* cnt = (unsigned*)(ws + O_CNT) + l * 8;
    int* s_item = (int*)(smem0 + SMEM_ITEM);
    const bf16_t* GATE = (const bf16_t*)(ws + O_GATE);
    bf16_t* YBo = (bf16_t*)(ws + O_YB);
    const int myx = (int)(xb_xcc_id() & 7u), hf = vhalf();
    int vict = 0;
    while (true) {
        __syncthreads();
        if (threadIdx.x == 0) {
            int code = -1;
            while (vict < 8) {
                const int x = (myx + vict) & 7;
                const unsigned idx = atomicAdd(cnt + x, 1u);
                if (idx < 256u) { code = x * 256 + (int)idx; break; }
                ++vict;
            }
            *s_item = code;
        }
        __syncthreads();
        const int code = *s_item;
        if (code < 0) break;
        const int x = code >> 8, idx = code & 255, bh = x + 8 * hf, b = bh >> 2, head = bh & 3;
        if (idx < 192) {
            const int qb = 63 - idx / 3, br = idx % 3, q0 = qb * 128, nt = 2 * qb + 2;
            if (br == 0) {
                attn_item<64, 1, true>((const bf16_t*)(ws + O_SBQ) + ((size_t)bh * S_ + q0) * 64, (const bf16_t*)(ws + O_SBK) + (size_t)bh * S_ * 64,
                                 (const bf16_t*)(ws + O_SBVT) + (size_t)bh * 64 * S_, S_, nullptr, q0, nt, GATE + ((size_t)b * S_ + q0) * 1024 + 256 + head * 64, YBo + ((size_t)b * S_ + q0) * 1024 + 256 + head * 64, smem, smem0, hf);
            } else if (br == 1) {
                attn_item<96, 0, false>((const bf16_t*)(ws + O_MQ) + ((size_t)bh * S_ + q0) * 96, (const bf16_t*)(ws + O_MK) + (size_t)bh * S_ * 96,
                                 (const bf16_t*)(ws + O_MVT) + (size_t)bh * 64 * S_, S_, nullptr, q0, nt, GATE + ((size_t)b * S_ + q0) * 1024 + head * 64, YBo + ((size_t)b * S_ + q0) * 1024 + head * 64, smem, smem0, hf);
            } else {
                attn_item<64, 0, true>((const bf16_t*)(ws + O_FQ) + ((size_t)bh * S_ + q0) * 64, (const bf16_t*)(ws + O_FK) + (size_t)bh * S_ * 64,
                                 (const bf16_t*)(ws + O_FVT) + (size_t)bh * 64 * S_, S_, (const float*)(ws + O_FC) + (size_t)bh * S_, q0, nt,
                                 GATE + ((size_t)b * S_ + q0) * 1024 + 512 + head * 64, YBo + ((size_t)b * S_ + q0) * 1024 + 512 + head * 64, smem, smem0, hf,
                                 sqrtf(((const float*)(ws + O_KMAX))[bh]) * 1.0002f);
            }
        } else {
            const int qb = idx - 192, q0 = qb * 128;
            attn_item<64, 2, false>((const bf16_t*)(ws + O_MEMQ) + ((size_t)bh * S_ + q0) * 64, (const bf16_t*)(ws + O_MEMK) + (size_t)bh * 256 * 64,
                             (const bf16_t*)(ws + O_MEMVT) + (size_t)bh * 64 * 256, 256, nullptr, q0, 4, GATE + ((size_t)b * S_ + q0) * 1024 + 768 + head * 64, YBo + ((size_t)b * S_ + q0) * 1024 + 768 + head * 64, smem, smem0, hf);
        }
    }
}

struct Stg4 { u32x4 a[2]; u32x4 b[2]; };
DI void stg4_issue(Stg4& st, const bf16_t* A, unsigned oa, unsigned sa, const bf16_t* B, unsigned ob, unsigned sb) {
#pragma unroll
    for (int j = 0; j < 2; ++j) { st.a[j] = *(const u32x4*)((const unsigned char*)A + (oa + j * sa)); st.b[j] = *(const u32x4*)((const unsigned char*)B + (ob + j * sb)); }
}
DI void stg4_commit(const Stg4& st, bf16_t* sA, bf16_t* sB, int srow, int skc) {
#pragma unroll
    for (int j = 0; j < 2; ++j) { *(u32x4*)(sA + (srow + 64 * j) * LS + skc) = st.a[j]; *(u32x4*)(sB + (srow + 64 * j) * LS + skc) = st.b[j]; }
}
DI void phase4(const Params& p, int l, unsigned char* smem) {
    unsigned char* ws = p.ws; asm volatile("" : "+s"(ws));
    const int tid = tid8_op(), lane = tid & 63, w = __builtin_amdgcn_readfirstlane(tid >> 6), wr = w >> 2, wc = w & 3, r = lane & 31, h = lane >> 5;
    const bf16_t* YB = (const bf16_t*)(ws + O_YB); const bf16_t* MR = (const bf16_t*)(ws + O_MR);
    const bf16_t* WMU = (const bf16_t*)(ws + O_WMU + l * SZ_WMU); const bf16_t* WBR = (const bf16_t*)(ws + O_WBR + l * SZ_WBR);
    const int G = gridDim.x, ntl = 2048, vb = blockIdx.x;
    if (vb >= ntl) return;
    const int nmine = (ntl - vb + G - 1) / G, gmax = nmine * 24 - 1;
    bf16_t* sA = (bf16_t*)smem; bf16_t* sB = sA + 2 * TILE_E;
    const int srow = tid >> 3, skc = (tid & 7) * 8;
    const unsigned o128 = (unsigned)((srow * 128 + skc) * 2), s128 = 128u * 128u, o1024 = (unsigned)((srow * 1024 + skc) * 2), s1024 = 1024u * 128u;
    auto ISS = [&](Stg4& R, int g) {
        g = g < gmax ? g : gmax;
        const int i = g / 24, v = g - i * 24, n = v / 6, jj = v - n * 6;
        const int t = vb + i * G, xcd = t & 7, j = t >> 3, m0 = (32 * xcd + (j >> 3)) * 128, c0 = (j & 7) * 128;
        if (jj < 2) stg4_issue(R, MR + (size_t)m0 * 128 + jj * 64, o128, s128, WMU + (size_t)(n * 1024 + c0) * 128 + jj * 64, o128, s128);
        else stg4_issue(R, YB + (size_t)m0 * 1024 + n * 256 + (jj - 2) * 64, o1024, s1024, WBR + (size_t)c0 * 1024 + n * 256 + (jj - 2) * 64, o1024, s1024);
    };
    Stg4 R0, R1;
    ISS(R0, 0); ISS(R1, 1);
    stg4_commit(R0, sA, sB, srow, skc);
    ISS(R0, 2);
#pragma unroll 1
    for (int it = 0; it < nmine; ++it) {
        const int t = vb + it * G;
        const int xcd = t & 7, j = t >> 3, m0 = (32 * xcd + (j >> 3)) * 128, c0 = (j & 7) * 128;
        f32x16 mg[2];
#pragma unroll
        for (int i = 0; i < 16; ++i) { mg[0][i] = 0.f; mg[1][i] = 0.f; }
#pragma unroll 1
        for (int n = 0; n < 4; ++n) {
            const int g0 = it * 24 + n * 6;
            f32x16 g[2], y[2];
#pragma unroll
            for (int i = 0; i < 16; ++i) { g[0][i] = 0.f; g[1][i] = 0.f; y[0][i] = 0.f; y[1][i] = 0.f; }
            __syncthreads(); mma21(g, sA, sB, wr, wc, r, h); stg4_commit(R1, sA + TILE_E, sB + TILE_E, srow, skc); ISS(R1, g0 + 3);
            __syncthreads(); mma21(g, sA + TILE_E, sB + TILE_E, wr, wc, r, h); stg4_commit(R0, sA, sB, srow, skc); ISS(R0, g0 + 4);
#pragma unroll
            for (int mi = 0; mi < 2; ++mi)
#pragma unroll
                for (int i = 0; i < 16; ++i) g[mi][i] = __builtin_amdgcn_rcpf(1.f + fexp2(-g[mi][i] * LOG2E));
            __syncthreads(); mma21(y, sA, sB, wr, wc, r, h); stg4_commit(R1, sA + TILE_E, sB + TILE_E, srow, skc); ISS(R1, g0 + 5);
            __syncthreads(); mma21(y, sA + TILE_E, sB + TILE_E, wr, wc, r, h); stg4_commit(R0, sA, sB, srow, skc); ISS(R0, g0 + 6);
            __syncthreads(); mma21(y, sA, sB, wr, wc, r, h); stg4_commit(R1, sA + TILE_E, sB + TILE_E, srow, skc); ISS(R1, g0 + 7);
            __syncthreads(); mma21(y, sA + TILE_E, sB + TILE_E, wr, wc, r, h); stg4_commit(R0, sA, sB, srow, skc); ISS(R0, g0 + 8);
#pragma unroll
            for (int mi = 0; mi < 2; ++mi)
#pragma unroll
                for (int i = 0; i < 16; ++i) mg[mi][i] += g[mi][i] * y[mi][i];
        }
        bf16_t* pb = (bf16_t*)(ws + O_XB) + (size_t)(m0 + 64 * wr + 4 * h) * 1024 + c0 + 32 * wc + r;
#pragma unroll
        for (int mi = 0; mi < 2; ++mi)
#pragma unroll
            for (int qd = 0; qd < 4; ++qd) {
                bf16_t* q = opaque(pb + (size_t)(32 * mi + 8 * qd) * 1024);
#pragma unroll
                for (int e = 0; e < 4; ++e) q[e * 1024] = tobf(mg[mi][4 * qd + e]);
            }
        __builtin_amdgcn_s_waitcnt(0x0F70);
    }
}

struct EpiP5 {
    static constexpr bool PERM = true, AFTER_DRAIN = false;
    const float* x; float* out; const float* st; const float* lg; const float* lb; int l;
    DI void operator()(const pg8::f32x4 (&acc)[2][2][4][2], const pg8::Unit& u, int wr, int wc, int fr, int fq) const {
        const int rowb = u.pm * 256 + wr * 64 + fr;
#pragma unroll
        for (int bj = 0; bj < 2; ++bj) {
            const int col0 = u.pn * 256 + bj * 128 + wc * 32 + 8 * fq;
            f32x4 g0 = {1.f, 1.f, 1.f, 1.f}, g1 = g0, b0 = {0.f, 0.f, 0.f, 0.f}, b1 = b0;
            if (l > 0) { g0 = *(const f32x4*)(lg + col0); g1 = *(const f32x4*)(lg + col0 + 4); b0 = *(const f32x4*)(lb + col0); b1 = *(const f32x4*)(lb + col0 + 4); }
            const float* src = (l == 0) ? x : (const float*)out;
#pragma unroll
            for (int ai = 0; ai < 2; ++ai) {
                const size_t i0 = (size_t)(rowb + ai * 128) * 1024 + col0;
                const float* ps = opaque(src + i0);
                f32x4 xa[4], xb_[4]; f32x2 sv[4];
#pragma unroll
                for (int m = 0; m < 4; ++m) {
                    xa[m] = *(const f32x4*)(ps + (size_t)(m * 16) * 1024); xb_[m] = *(const f32x4*)(ps + (size_t)(m * 16) * 1024 + 4);
                    if (l > 0) sv[m] = *(const f32x2*)(st + 2 * (rowb + ai * 128 + m * 16));
                }
                float* po = opaque(out + i0);
#pragma unroll
                for (int m = 0; m < 4; ++m) {
                    f32x4 x0 = xa[m], x1 = xb_[m];
                    if (l > 0) { x0 = (x0 - sv[m].x) * sv[m].y * g0 + b0; x1 = (x1 - sv[m].x) * sv[m].y * g1 + b1; }
                    *(f32x4*)(po + (size_t)(m * 16) * 1024) = x0 * DN_ALPHA + acc[ai][bj][m][0];
                    *(f32x4*)(po + (size_t)(m * 16) * 1024 + 4) = x1 * DN_ALPHA + acc[ai][bj][m][1];
                }
            }
        }
    }
};
DI void phase5(const Params& p, int l, unsigned char* smem) {
    unsigned char* ws = p.ws; asm volatile("" : "+s"(ws));
    pg8::Gemm g; g.A = (const bf16_t*)(ws + O_XB); g.Bt = (const bf16_t*)(ws + O_WOUT + l * SZ_WOUT); g.M = T_; g.N = 1024; g.K = 1024;
    pg8::StaticOrder S; S.init(T_, 1024, (int)gridDim.x, (int)blockIdx.x);
    EpiP5 E; E.x = p.x; E.out = p.out; E.st = (const float*)(ws + O_STATS); E.lg = p.ln_g + (l > 0 ? (l - 1) * 1024 : 0); E.lb = p.ln_b + (l > 0 ? (l - 1) * 1024 : 0); E.l = l;
    pg8::gemm_phase<EpiP5, pg8::StaticOrder, true, true>((PG8_LAS unsigned char*)smem, g, S, E);
}

DI void phase6(const Params& p, int l) {
    unsigned char* ws = p.ws; asm volatile("" : "+s"(ws));
    const int tidq = tid_op(), lane = tidq & 63, w = tidq >> 6;
    const float* G = p.ln_g + l * 1024; const float* Bv = p.ln_b + l * 1024;
    f32x4 g[4], bb[4];
#pragma unroll
    for (int j = 0; j < 4; ++j) { g[j] = *(const f32x4*)(G + 256 * j + 4 * lane); bb[j] = *(const f32x4*)(Bv + 256 * j + 4 * lane); }
    const int nw = VG * 4;
    for (int row0 = VB * 4 + w; row0 < T_; row0 += 2 * nw) {
        f32x4 v[2][4];
#pragma unroll
        for (int u = 0; u < 2; ++u) {
            const int row = row0 + u * nw;
            if (row < T_) {
#pragma unroll
                for (int j = 0; j < 4; ++j) v[u][j] = *(const f32x4*)(p.out + (size_t)row * 1024 + 256 * j + 4 * lane);
            }
        }
#pragma unroll
        for (int u = 0; u < 2; ++u) {
            const int row = row0 + u * nw;
            if (row >= T_) continue;
            float* pr = p.out + (size_t)row * 1024;
            float s = 0.f;
#pragma unroll
            for (int j = 0; j < 4; ++j) s += (v[u][j].x + v[u][j].y) + (v[u][j].z + v[u][j].w);
#pragma unroll
            for (int d = 32; d >= 1; d >>= 1) s += __shfl_xor(s, d);
            const float mu = s * (1.f / 1024.f);
            float q = 0.f;
#pragma unroll
            for (int j = 0; j < 4; ++j) { const f32x4 d = v[u][j] - mu; q += (d.x * d.x + d.y * d.y) + (d.z * d.z + d.w * d.w); }
#pragma unroll
            for (int d = 32; d >= 1; d >>= 1) q += __shfl_xor(q, d);
            const float rstd = rsqrtf(q * (1.f / 1024.f) + 1e-5f);
            if (l == 3) {
#pragma unroll
                for (int j = 0; j < 4; ++j) *(f32x4*)(pr + 256 * j + 4 * lane) = (v[u][j] - mu) * rstd * g[j] + bb[j];
            } else {
                if (lane == 0) { f32x2 st = {mu, rstd}; *(f32x2*)((float*)(ws + O_STATS) + 2 * row) = st; }
                bf16_t* xb = (bf16_t*)(ws + O_XB) + (size_t)row * 1024;
#pragma unroll
                for (int j = 0; j < 4; ++j) {
                    const f32x4 y = (v[u][j] - mu) * rstd * g[j] + bb[j];
                    u32x2 o; o.x = pk2(y.x, y.y); o.y = pk2(y.z, y.w);
                    *(u32x2*)(xb + 256 * j + 4 * lane) = o;
                }
            }
        }
    }
}

#define XB_TMO      128
#define XB_XCNT(j)  (256  + 64 * (j))
#define XB_XSUB(j)  (1280 + 64 * (j))
#define XB_XGEN(j)  (2304 + 64 * (j))
#define XB_TOP      3328
#define XB_TOPGEN   3392
#define XCD_BAR_WORDS 3456
#define XB_SPIN_CAP (1u << 18)
#define LAS __attribute__((address_space(3)))
DI unsigned xb_ld(unsigned* p)              { return __hip_atomic_load(p, __ATOMIC_RELAXED, __HIP_MEMORY_SCOPE_AGENT); }
DI unsigned xb_add(unsigned* p, unsigned v) { return __hip_atomic_fetch_add(p, v, __ATOMIC_RELAXED, __HIP_MEMORY_SCOPE_AGENT); }
#define XB_SPIN(cond, bar) do { unsigned _sp = 0; while (cond) { __builtin_amdgcn_s_sleep(1); \
    if ((++_sp & 255u) == 0u) { if (xb_ld(&(bar)[XB_TMO])) break; if (_sp > XB_SPIN_CAP) { atomicAdd(&(bar)[XB_TMO], 1u); break; } } } } while (0)
struct XcdBarrier { unsigned* bar; unsigned x; volatile LAS unsigned* st; };
DI XcdBarrier xcd_barrier_post(unsigned* bar, volatile LAS unsigned* st) {
    XcdBarrier b; b.bar = bar; b.x = xb_xcc_id(); b.st = st;
    if (threadIdx.x == 0) (void)xb_add(&bar[XB_XCNT(b.x)], 1u);
    return b;
}
DI void xcd_barrier_complete(unsigned* bar, unsigned x, unsigned& nloc, unsigned& nx) {
    const unsigned G = gridDim.x * gridDim.y * gridDim.z;
    unsigned sum, cnt, mine, sp = 0u;
    for (;;) {
        sum = 0u; cnt = 0u; mine = 0u;
#pragma unroll
        for (unsigned j = 0; j < 16; ++j) { const unsigned c = xb_ld(&bar[XB_XCNT(j)]); sum += c; cnt += (c > 0u) ? 1u : 0u; mine = (j == x) ? c : mine; }
        if (sum == G) break;
        __builtin_amdgcn_s_sleep(1);
        if ((++sp & 255u) == 0u) { if (xb_ld(&bar[XB_TMO])) break; if (sp > XB_SPIN_CAP) { atomicAdd(&bar[XB_TMO], 1u); break; } }
    }
    nloc = mine > 0u ? mine : 1u; nx = cnt > 0u ? cnt : 1u;
}
DI void xcd_barrier(const XcdBarrier& b) {
    asm volatile("s_waitcnt vmcnt(0)" ::: "memory");
    __syncthreads();
    if (threadIdx.x == 0) {
        unsigned* bar = b.bar; asm volatile("" : "+s"(bar));
        const unsigned bx = xb_xcc_id();
        __builtin_amdgcn_s_waitcnt(0);
        unsigned nloc = b.st[0], nx = b.st[1];
        if (nloc == 0u) { xcd_barrier_complete(bar, bx, nloc, nx); b.st[0] = nloc; b.st[1] = nx; }
        const unsigned old = xb_add(&bar[XB_XSUB(bx)], 1u);
        const unsigned gen = old / nloc;
        if (old + 1u == (gen + 1u) * nloc) {
            __builtin_amdgcn_fence(__ATOMIC_RELEASE, "agent");
            asm volatile("s_waitcnt vmcnt(0)" ::: "memory");
            const unsigned og = xb_add(&bar[XB_TOP], 1u);
            const unsigned tg = og / nx;
            if (og + 1u == (tg + 1u) * nx) xb_add(&bar[XB_TOPGEN], 1u);
            else XB_SPIN(xb_ld(&bar[XB_TOPGEN]) == tg, bar);
            __builtin_amdgcn_fence(__ATOMIC_ACQUIRE, "agent");
            xb_add(&bar[XB_XGEN(bx)], 1u);
            asm volatile("s_waitcnt vmcnt(0)" ::: "memory");
        } else {
            XB_SPIN(xb_ld(&bar[XB_XGEN(bx)]) == gen, bar);
            __builtin_amdgcn_fence(__ATOMIC_ACQUIRE, "agent");
            asm volatile("s_waitcnt vmcnt(0)" ::: "memory");
        }
    }
    __syncthreads();
}

constexpr int SMEM_WG = 2 * HALF_SMEM;
#if MK_MULTI
template <int PH> __global__ void __launch_bounds__(512) phase_kernel(Params p, int l) {
    __shared__ __attribute__((aligned(16))) unsigned char smem[SMEM_WG];
    unsigned char* hs = smem + vhalf() * HALF_SMEM;
    if (PH == 0) prologue(p, hs);
    if (PH == 1) phase1(p, l, smem);
    if (PH == 2) { phase2_gemms(p, l, smem); phase2(p, l, hs); }
    if (PH == 3) phase3(p, l, hs, smem);
    if (PH == 4) phase4(p, l, smem);
    if (PH == 5) phase5(p, l, smem);
    if (PH == 6) phase6(p, l);
}
#else
__global__ void __launch_bounds__(512) mega_kernel(Params p) {
    __shared__ __attribute__((aligned(16))) unsigned char smem[SMEM_WG];
    __shared__ uint4 xb_words;
    cg::grid_group grid = cg::this_grid();
    if (p.ws == nullptr) grid.sync();
    if (threadIdx.x == 0) xb_words = make_uint4(0u, 0u, 0u, 0u);
    __syncthreads();
    const XcdBarrier xb = xcd_barrier_post((unsigned*)(p.ws + O_BAR), (volatile LAS unsigned*)&xb_words);
    unsigned char* hs = smem + vhalf() * HALF_SMEM;
    prologue(p, hs);
    xcd_barrier(xb);
    for (int l = 0; l < 4; ++l) {
        for (int rep = 0; rep < REP1; ++rep) { phase1(p, l, smem); xcd_barrier(xb); }
        for (int rep = 0; rep < REP2; ++rep) { phase2_gemms(p, l, smem); phase2(p, l, hs); xcd_barrier(xb); }
        for (int rep = 0; rep < REP3; ++rep) { phase3(p, l * REP3 + rep, hs, smem); xcd_barrier(xb); }
        for (int rep = 0; rep < REP4; ++rep) { phase4(p, l, smem); xcd_barrier(xb); }
        phase5(p, l, smem); xcd_barrier(xb);
        phase6(p, l);
        if (l < 3) xcd_barrier(xb);
    }
}
#endif

extern "C" void kernel_launch(void* const* d_in, const int* in_sizes, int n_in, void* d_out, int out_size, void* d_ws, size_t ws_size, hipStream_t stream) {
    Params p{};
    p.x = (const float*)d_in[0]; p.mem = (const float*)d_in[1]; p.pos = (const int*)d_in[2]; p.w_in = (const float*)d_in[3];
    p.q_norm = (const float*)d_in[4]; p.w_qb = (const float*)d_in[5]; p.kv_norm = (const float*)d_in[6]; p.w_kvb = (const float*)d_in[7];
    p.fox_bias = (const float*)d_in[8]; p.w_mem_kv = (const float*)d_in[9]; p.w_merge_up = (const float*)d_in[10]; p.w_branch = (const float*)d_in[11];
    p.w_out = (const float*)d_in[12]; p.ln_g = (const float*)d_in[13]; p.ln_b = (const float*)d_in[14];
    p.out = (float*)d_out; p.ws = (unsigned char*)d_ws;
    if (ws_size < O_END) { fprintf(stderr, "workspace too small: %zu < %zu\n", ws_size, (size_t)O_END); return; }
#if MK_MULTI
    const int G = 256;
    phase_kernel<0><<<G, 512, 0, stream>>>(p, 0);
    for (int l = 0; l < 4; ++l) {
        phase_kernel<1><<<G, 512, 0, stream>>>(p, l);
        phase_kernel<2><<<G, 512, 0, stream>>>(p, l);
        phase_kernel<3><<<G, 512, 0, stream>>>(p, l);
        phase_kernel<4><<<G, 512, 0, stream>>>(p, l);
        phase_kernel<5><<<G, 512, 0, stream>>>(p, l);
        phase_kernel<6><<<G, 512, 0, stream>>>(p, l);
    }
#else
    static int grid_blocks = 0;
    if (!grid_blocks) {
        int dev = 0, cus = 0, per_cu = 0;
        hipGetDevice(&dev);
        hipDeviceGetAttribute(&cus, hipDeviceAttributeMultiprocessorCount, dev);
        hipOccupancyMaxActiveBlocksPerMultiprocessor(&per_cu, mega_kernel, 512, 0);
        if (per_cu > 1) per_cu = 1;
        grid_blocks = cus * per_cu;
    }
    hipMemsetAsync((unsigned char*)d_ws + O_CNT, 0, O_YB - O_CNT, stream);
    void* args[] = {&p};
    hipError_t e = hipLaunchCooperativeKernel((void*)mega_kernel, dim3(grid_blocks), dim3(512), args, 0, stream);
    if (e != hipSuccess) fprintf(stderr, "cooperative launch failed: %s (grid %d)\n", hipGetErrorString(e), grid_blocks);
#endif
}
```

```cpp
#include <hip/hip_runtime.h>
#include <hip/hip_cooperative_groups.h>
#include <cstdio>
#include <cstdint>
namespace cg = cooperative_groups;

#ifndef MK_MULTI
#define MK_MULTI 0
#endif

#ifndef REP1
#define REP1 1
#endif
#ifndef REP2
#define REP2 1
#endif
#ifndef REP3
#define REP3 1
#endif
#ifndef REP4
#define REP4 1
#endif
#define DI __device__ __forceinline__
typedef unsigned short bf16_t;
typedef short bf16x8 __attribute__((ext_vector_type(8)));
typedef short s16x4 __attribute__((ext_vector_type(4)));
typedef float f32x16 __attribute__((ext_vector_type(16)));
typedef float f32x4 __attribute__((ext_vector_type(4)));
typedef float f32x2 __attribute__((ext_vector_type(2)));
typedef unsigned u32x4 __attribute__((ext_vector_type(4)));
typedef unsigned u32x2 __attribute__((ext_vector_type(2)));
typedef __bf16 bf2_t __attribute__((ext_vector_type(2)));

constexpr int S_ = 8192, T_ = 4 * 8192, NIN = 3840;
constexpr float LOG2E = 1.4426950408889634f;
constexpr float DN_ALPHA = 1.681792830507429f;

constexpr size_t SZ_WIN = (size_t)NIN * 1024 * 2, SZ_WQB = 512 * 384 * 2  , SZ_WKVB = 512 * 256 * 2, SZ_WMEM = 512 * 1024 * 2,
                 SZ_WMU = 4096 * 128 * 2, SZ_WBR = 1024 * 1024 * 2, SZ_WOUT = 1024 * 1024 * 2;
constexpr size_t O_WIN = 0;
constexpr size_t O_WQB = O_WIN + 4 * SZ_WIN;
constexpr size_t O_WKVB = O_WQB + 4 * SZ_WQB;
constexpr size_t O_WMEM = O_WKVB + 4 * SZ_WKVB;
constexpr size_t O_WMU = O_WMEM + 4 * SZ_WMEM;
constexpr size_t O_WBR = O_WMU + 4 * SZ_WMU;
constexpr size_t O_WOUT = O_WBR + 4 * SZ_WBR;
constexpr size_t O_XB = O_WOUT + 4 * SZ_WOUT;
constexpr size_t O_CQ = O_XB + (size_t)T_ * 1024 * 2;
constexpr size_t O_CKV = O_CQ + (size_t)T_ * 384 * 2;
constexpr size_t O_SBQ = O_CKV + (size_t)T_ * 256 * 2;
constexpr size_t O_SBK = O_SBQ + (size_t)T_ * 256 * 2;
constexpr size_t O_SBVT = O_SBK + (size_t)T_ * 256 * 2;
constexpr size_t O_FQ = O_SBVT + (size_t)T_ * 256 * 2;
constexpr size_t O_FK = O_FQ + (size_t)T_ * 256 * 2;
constexpr size_t O_FVT = O_FK + (size_t)T_ * 256 * 2;
constexpr size_t O_MEMQ = O_FVT + (size_t)T_ * 256 * 2;
constexpr size_t O_GATE = O_MEMQ + (size_t)T_ * 256 * 2;
constexpr size_t O_MR = O_GATE + (size_t)T_ * 1024 * 2;
constexpr size_t O_TAIL = O_MR + (size_t)T_ * 128 * 2;
constexpr size_t O_FL = O_TAIL + (size_t)T_ * 32 * 4;
constexpr size_t O_MQ = O_FL + (size_t)T_ * 4 * 4;
constexpr size_t O_MK = O_MQ + (size_t)T_ * 384 * 2;
constexpr size_t O_MVT = O_MK + (size_t)T_ * 384 * 2;
constexpr size_t O_FC = O_MVT + (size_t)T_ * 256 * 2;
constexpr size_t O_MEMB = O_FC + (size_t)T_ * 4 * 4;
constexpr size_t O_MEMK = O_MEMB + (size_t)1024 * 1024 * 2;
constexpr size_t O_MEMVT = O_MEMK + (size_t)16 * 256 * 64 * 2;
constexpr size_t O_STATS = O_MEMVT + (size_t)16 * 256 * 64 * 2;
constexpr size_t O_COS = O_STATS + (size_t)T_ * 2 * 4;
constexpr size_t O_SIN = O_COS + (size_t)T_ * 16 * 4;
constexpr size_t O_CNT = O_SIN + (size_t)T_ * 16 * 4;
constexpr size_t O_KMAX = O_CNT + 256;
constexpr size_t O_BAR = O_KMAX + 256;
constexpr size_t O_YB = O_BAR + 3456 * 4 + 256 - (3456 * 4) % 256;
constexpr size_t O_END = O_YB + (size_t)T_ * 1024 * 2;

struct Params {
    const float* x; const float* mem; const int* pos; const float* w_in; const float* q_norm; const float* w_qb; const float* kv_norm;
    const float* w_kvb; const float* fox_bias; const float* w_mem_kv; const float* w_merge_up; const float* w_branch; const float* w_out;
    const float* ln_g; const float* ln_b; float* out; unsigned char* ws;
};

DI unsigned pk2(float a, float b) { f32x2 v = {a, b}; return __builtin_bit_cast(unsigned, __builtin_convertvector(v, bf2_t)); }
DI bf16_t tobf(float a) { return (bf16_t)(pk2(a, 0.f) & 0xffffu); }
DI float bflo(unsigned u) { return __uint_as_float(u << 16); }
DI float bfhi(unsigned u) { return __uint_as_float(u & 0xffff0000u); }
DI int tid_op() { int t = threadIdx.x & 255; asm volatile("" : "+v"(t)); return t; }
DI int tid8_op() { int t = threadIdx.x; asm volatile("" : "+v"(t)); return t; }
DI int vhalf() { return __builtin_amdgcn_readfirstlane((int)(threadIdx.x >> 8)); }
#define VB ((int)blockIdx.x * 2 + vhalf())
#define VG ((int)gridDim.x * 2)
DI unsigned xb_xcc_id() { return (unsigned)__builtin_amdgcn_readfirstlane((int)(__builtin_amdgcn_s_getreg((3 << 11) | 20) & 0xFu)); }
DI float xhalf_max(float x) { auto r = __builtin_amdgcn_permlane32_swap(__float_as_uint(x), __float_as_uint(x), false, false); return fmaxf(__uint_as_float(r[0]), __uint_as_float(r[1])); }
DI float xhalf_other(float x, int h) { auto r = __builtin_amdgcn_permlane32_swap(__float_as_uint(x), __float_as_uint(x), false, false); return h ? __uint_as_float(r[0]) : __uint_as_float(r[1]); }
DI int crow(int i, int h) { return (i & 3) + 8 * (i >> 2) + 4 * h; }
#define MFMA32(a, b, c) __builtin_amdgcn_mfma_f32_32x32x16_bf16((a), (b), (c), 0, 0, 0)
DI float fexp2(float x) { return __builtin_amdgcn_exp2f(x); }
DI float flog2(float x) { return __builtin_amdgcn_logf(x); }
DI void zero4(f32x16 (&a)[2][2]) {
#pragma unroll
    for (int i = 0; i < 2; ++i)
#pragma unroll
        for (int j = 0; j < 2; ++j)
#pragma unroll
            for (int k = 0; k < 16; ++k) a[i][j][k] = 0.f;
}

constexpr int LS = 72;
constexpr int TILE_E = 128 * LS;
constexpr int SMEM_GEMM = 4 * TILE_E * 2;
constexpr int SMEM_RS = SMEM_GEMM;
constexpr int SMEM_ITEM = SMEM_GEMM + 512;
constexpr int SMEM_FLAG = SMEM_GEMM + 640;
constexpr int SMEM_TOTAL = SMEM_GEMM + 1024;
constexpr int HALF_SMEM = SMEM_TOTAL;

DI void g_load(u32x4 (&ra)[4], u32x4 (&rb)[4], const bf16_t* A, unsigned oa, unsigned sa, const bf16_t* Bt, unsigned ob, unsigned sb) {
#pragma unroll
    for (int j = 0; j < 4; ++j) {
        ra[j] = *(const u32x4*)((const unsigned char*)A + (oa + j * sa));
        rb[j] = *(const u32x4*)((const unsigned char*)Bt + (ob + j * sb));
    }
}
DI void g_store(const u32x4 (&ra)[4], const u32x4 (&rb)[4], bf16_t* sa, bf16_t* sb, int tid) {
#pragma unroll
    for (int j = 0; j < 4; ++j) {
        const int c = tid + 256 * j, row = c >> 3, kc = (c & 7) * 8;
        *(u32x4*)(sa + row * LS + kc) = ra[j];
        *(u32x4*)(sb + row * LS + kc) = rb[j];
    }
}
DI void gemm_accum(f32x16 (&acc)[2][2], const bf16_t* A, int lda, const bf16_t* Bt, int ldb, int nk, unsigned char* smem) {
    const int tid = tid_op(), lane = tid & 63, w = tid >> 6, wr = w >> 1, wc = w & 1, r = lane & 31, h = lane >> 5;
    bf16_t* sA = (bf16_t*)smem;
    bf16_t* sB = sA + 2 * TILE_E;
    u32x4 ra[4], rb[4];
    const unsigned oa = (unsigned)(((tid >> 3) * lda + (tid & 7) * 8) * 2), ob = (unsigned)(((tid >> 3) * ldb + (tid & 7) * 8) * 2);
    const unsigned sa = (unsigned)(lda * 64), sb = (unsigned)(ldb * 64);
    g_load(ra, rb, A, oa, sa, Bt, ob, sb);
    __syncthreads();
    g_store(ra, rb, sA, sB, tid);
#pragma unroll 1
    for (int kt = 0; kt < nk; ++kt) {
        const int buf = kt & 1;
        if (kt + 1 < nk) g_load(ra, rb, A + (kt + 1) * 64, oa, sa, Bt + (kt + 1) * 64, ob, sb);
        __syncthreads();
        const bf16_t* a = sA + buf * TILE_E + (wr * 64 + r) * LS + h * 8;
        const bf16_t* b = sB + buf * TILE_E + (wc * 64 + r) * LS + h * 8;
#pragma unroll
        for (int s = 0; s < 4; ++s) {
            const bf16x8 a0 = *(const bf16x8*)(a + s * 16), a1 = *(const bf16x8*)(a + 32 * LS + s * 16);
            const bf16x8 b0 = *(const bf16x8*)(b + s * 16), b1 = *(const bf16x8*)(b + 32 * LS + s * 16);
            acc[0][0] = MFMA32(a0, b0, acc[0][0]);
            acc[0][1] = MFMA32(a0, b1, acc[0][1]);
            acc[1][0] = MFMA32(a1, b0, acc[1][0]);
            acc[1][1] = MFMA32(a1, b1, acc[1][1]);
        }
        if (kt + 1 < nk) g_store(ra, rb, sA + (buf ^ 1) * TILE_E, sB + (buf ^ 1) * TILE_E, tid);
    }
}

DI void gemm_accum_n1(f32x16 (&acc)[2], const bf16_t* A, int lda, const bf16_t* Bt, int ldb, int nk, unsigned char* smem) {
    const int tid = tid_op(), lane = tid & 63, w = tid >> 6, wr = w >> 1, wc = w & 1, r = lane & 31, h = lane >> 5;
    bf16_t* sA = (bf16_t*)smem;
    bf16_t* sB = sA + 2 * TILE_E;
    u32x4 ra[4], rb[2];
    const unsigned oa = (unsigned)(((tid >> 3) * lda + (tid & 7) * 8) * 2), ob = (unsigned)(((tid >> 3) * ldb + (tid & 7) * 8) * 2);
    const unsigned sa = (unsigned)(lda * 64), sb = (unsigned)(ldb * 64);
    const int srow = tid >> 3, skc = (tid & 7) * 8;
#pragma unroll
    for (int j = 0; j < 4; ++j) ra[j] = *(const u32x4*)((const unsigned char*)A + (oa + j * sa));
#pragma unroll
    for (int j = 0; j < 2; ++j) rb[j] = *(const u32x4*)((const unsigned char*)Bt + (ob + j * sb));
    __syncthreads();
#pragma unroll
    for (int j = 0; j < 4; ++j) *(u32x4*)(sA + (srow + 32 * j) * LS + skc) = ra[j];
#pragma unroll
    for (int j = 0; j < 2; ++j) *(u32x4*)(sB + (srow + 32 * j) * LS + skc) = rb[j];
#pragma unroll 1
    for (int kt = 0; kt < nk; ++kt) {
        const int buf = kt & 1;
        if (kt + 1 < nk) {
#pragma unroll
            for (int j = 0; j < 4; ++j) ra[j] = *(const u32x4*)((const unsigned char*)(A + (kt + 1) * 64) + (oa + j * sa));
#pragma unroll
            for (int j = 0; j < 2; ++j) rb[j] = *(const u32x4*)((const unsigned char*)(Bt + (kt + 1) * 64) + (ob + j * sb));
        }
        __syncthreads();
        const bf16_t* a = sA + buf * TILE_E + (wr * 64 + r) * LS + h * 8;
        const bf16_t* b = sB + buf * TILE_E + (wc * 32 + r) * LS + h * 8;
#pragma unroll
        for (int s = 0; s < 4; ++s) {
            const bf16x8 a0 = *(const bf16x8*)(a + s * 16), a1 = *(const bf16x8*)(a + 32 * LS + s * 16);
            const bf16x8 b0 = *(const bf16x8*)(b + s * 16);
            acc[0] = MFMA32(a0, b0, acc[0]);
            acc[1] = MFMA32(a1, b0, acc[1]);
        }
        if (kt + 1 < nk) {
#pragma unroll
            for (int j = 0; j < 4; ++j) *(u32x4*)(sA + (buf ^ 1) * TILE_E + (srow + 32 * j) * LS + skc) = ra[j];
#pragma unroll
            for (int j = 0; j < 2; ++j) *(u32x4*)(sB + (buf ^ 1) * TILE_E + (srow + 32 * j) * LS + skc) = rb[j];
        }
    }
}

template <int NB> struct Stg { u32x4 a[4]; u32x4 b[NB]; };
template <int NB> DI void stg_issue(Stg<NB>& st, const bf16_t* A, unsigned oa, unsigned sa, const bf16_t* B, unsigned ob, unsigned sb) {
#pragma unroll
    for (int j = 0; j < 4; ++j) st.a[j] = *(const u32x4*)((const unsigned char*)A + (oa + j * sa));
#pragma unroll
    for (int j = 0; j < NB; ++j) st.b[j] = *(const u32x4*)((const unsigned char*)B + (ob + j * sb));
}
template <int NB> DI void stg_commit(const Stg<NB>& st, bf16_t* sA, bf16_t* sB, int srow, int skc) {
#pragma unroll
    for (int j = 0; j < 4; ++j) *(u32x4*)(sA + (srow + 32 * j) * LS + skc) = st.a[j];
#pragma unroll
    for (int j = 0; j < NB; ++j) *(u32x4*)(sB + (srow + 32 * j) * LS + skc) = st.b[j];
}
DI void mma22(f32x16 (&acc)[2][2], const bf16_t* sA, const bf16_t* sB, int wr, int wc, int r, int h) {
    const bf16_t* a = sA + (wr * 64 + r) * LS + h * 8;
    const bf16_t* b = sB + (wc * 64 + r) * LS + h * 8;
#pragma unroll
    for (int s = 0; s < 4; ++s) {
        const bf16x8 a0 = *(const bf16x8*)(a + s * 16), a1 = *(const bf16x8*)(a + 32 * LS + s * 16);
        const bf16x8 b0 = *(const bf16x8*)(b + s * 16), b1 = *(const bf16x8*)(b + 32 * LS + s * 16);
        acc[0][0] = MFMA32(a0, b0, acc[0][0]);
        acc[0][1] = MFMA32(a0, b1, acc[0][1]);
        acc[1][0] = MFMA32(a1, b0, acc[1][0]);
        acc[1][1] = MFMA32(a1, b1, acc[1][1]);
    }
}
DI void mma21(f32x16 (&acc)[2], const bf16_t* sA, const bf16_t* sB, int wr, int wc, int r, int h) {
    const bf16_t* a = sA + (wr * 64 + r) * LS + h * 8;
    const bf16_t* b = sB + (wc * 32 + r) * LS + h * 8;
#pragma unroll
    for (int s = 0; s < 4; ++s) {
        const bf16x8 a0 = *(const bf16x8*)(a + s * 16), a1 = *(const bf16x8*)(a + 32 * LS + s * 16);
        const bf16x8 b0 = *(const bf16x8*)(b + s * 16);
        acc[0] = MFMA32(a0, b0, acc[0]);
        acc[1] = MFMA32(a1, b0, acc[1]);
    }
}

constexpr int T256_E = 256 * LS;
struct Stg8 { u32x4 a[4]; u32x4 b[4]; };
DI void stg8_issue(Stg8& st, const bf16_t* A, const bf16_t* B, unsigned oab, unsigned sab) {
#pragma unroll
    for (int j = 0; j < 4; ++j) st.a[j] = *(const u32x4*)((const unsigned char*)A + (oab + j * sab));
#pragma unroll
    for (int j = 0; j < 4; ++j) st.b[j] = *(const u32x4*)((const unsigned char*)B + (oab + j * sab));
}
DI void stg8_commit(const Stg8& st, bf16_t* sA, bf16_t* sB, int srow, int skc) {
#pragma unroll
    for (int j = 0; j < 4; ++j) *(u32x4*)(sA + (srow + 64 * j) * LS + skc) = st.a[j];
#pragma unroll
    for (int j = 0; j < 4; ++j) *(u32x4*)(sB + (srow + 64 * j) * LS + skc) = st.b[j];
}
DI void mma8(f32x16 (&acc)[2][2][2], const bf16_t* sA, const bf16_t* sB, int wr, int wc, int r, int h) {
    const bf16_t* a = sA + (wr * 128 + r) * LS + h * 8;
    const bf16_t* b = sB + (wc * 64 + r) * LS + h * 8;
#define SCHED_ __builtin_amdgcn_sched_barrier(0)
#define WAITL0_ __builtin_amdgcn_s_waitcnt(0xC07F)
#define KSTEP_(S, A0, A1, B0, B1, N0, N1, NB0, NB1)                                                                         \
    WAITL0_;                                                                                                                 \
    a2 = *(const bf16x8*)(a + 64 * LS + (S) * 16); a3 = *(const bf16x8*)(a + 96 * LS + (S) * 16);                           \
    SCHED_;                                                                                                                  \
    acc[0][0][0] = MFMA32(A0, B0, acc[0][0][0]); acc[0][0][1] = MFMA32(A0, B1, acc[0][0][1]);                                \
    acc[0][1][0] = MFMA32(A1, B0, acc[0][1][0]); acc[0][1][1] = MFMA32(A1, B1, acc[0][1][1]);                                \
    SCHED_;                                                                                                                  \
    WAITL0_;                                                                                                                 \
    if ((S) < 3) { N0 = *(const bf16x8*)(a + ((S) + 1) * 16); N1 = *(const bf16x8*)(a + 32 * LS + ((S) + 1) * 16);           \
                   NB0 = *(const bf16x8*)(b + ((S) + 1) * 16); NB1 = *(const bf16x8*)(b + 32 * LS + ((S) + 1) * 16); }       \
    SCHED_;                                                                                                                  \
    acc[1][0][0] = MFMA32(a2, B0, acc[1][0][0]); acc[1][0][1] = MFMA32(a2, B1, acc[1][0][1]);                                \
    acc[1][1][0] = MFMA32(a3, B0, acc[1][1][0]); acc[1][1][1] = MFMA32(a3, B1, acc[1][1][1]);                                \
    SCHED_;
    bf16x8 p0 = *(const bf16x8*)(a), p1 = *(const bf16x8*)(a + 32 * LS), pb0 = *(const bf16x8*)(b), pb1 = *(const bf16x8*)(b + 32 * LS);
    bf16x8 q0, q1, qb0, qb1, a2, a3;
    KSTEP_(0, p0, p1, pb0, pb1, q0, q1, qb0, qb1)
    KSTEP_(1, q0, q1, qb0, qb1, p0, p1, pb0, pb1)
    KSTEP_(2, p0, p1, pb0, pb1, q0, q1, qb0, qb1)
    KSTEP_(3, q0, q1, qb0, qb1, p0, p1, pb0, pb1)
#undef KSTEP_
#undef WAITL0_
#undef SCHED_
}

template <typename T> DI T* opaque(T* p) { asm volatile("" : "+v"(p) : : "memory"); return p; }
DI void st_rm(const f32x16 (&acc)[2][2], bf16_t* base, int ld, float scale, int r, int h) {
    bf16_t* pb = base + (size_t)(4 * h) * ld + r;
#pragma unroll
    for (int mi = 0; mi < 2; ++mi)
#pragma unroll
        for (int qd = 0; qd < 4; ++qd) {
            bf16_t* q = opaque(pb + (size_t)(32 * mi + 8 * qd) * ld);
#pragma unroll
            for (int e = 0; e < 4; ++e)
#pragma unroll
                for (int ni = 0; ni < 2; ++ni) q[(size_t)e * ld + 32 * ni] = tobf(acc[mi][ni][4 * qd + e] * scale);
        }
}
DI void st_tr(const f32x16 (&acc)[2][2], bf16_t* base, int ld, float scale, int r, int h) {
    bf16_t* pb = base + (size_t)r * ld + 4 * h;
#pragma unroll
    for (int ni = 0; ni < 2; ++ni) {
        bf16_t* q = opaque(pb + (size_t)(32 * ni) * ld);
#pragma unroll
        for (int mi = 0; mi < 2; ++mi)
#pragma unroll
            for (int qd = 0; qd < 4; ++qd) {
                u32x2 v;
                v.x = pk2(acc[mi][ni][4 * qd] * scale, acc[mi][ni][4 * qd + 1] * scale);
                v.y = pk2(acc[mi][ni][4 * qd + 2] * scale, acc[mi][ni][4 * qd + 3] * scale);
                *(u32x2*)(q + 32 * mi + 8 * qd) = v;
            }
    }
}

DI int win_src_col(int n) {
    if (n < 640) return n;
    if (n < 2176) return n + 32;
    if (n < 3584) return n + 36;
    if (n < 3616) return n - 3584 + 640;
    if (n < 3620) return n - 3616 + 2208;
    return -1;
}
DI void transpose_job(const float* src, int srcN, int K, bf16_t* dst, int Ndst, const float* rs, bool winmap, unsigned char* smem, int nvalid = 1 << 30) {
    float* tl = (float*)smem;
    const int tid = tid_op(), tx = tid & 63, ty = tid >> 6, nkt = K / 64, ntiles = nkt * (Ndst / 64);
    for (int t = VB; t < ntiles; t += VG) {
        const int k0 = (t % nkt) * 64, n0 = (t / nkt) * 64;
        const int sc = winmap ? win_src_col(n0 + tx) : ((n0 + tx) < nvalid ? (n0 + tx) : -1);
        float tv[16];
#pragma unroll
        for (int i = 0; i < 16; ++i) {
            const int kk = ty + 4 * i;
            float v = 0.f;
            if (sc >= 0) { v = src[(size_t)(k0 + kk) * srcN + sc]; if (rs) v *= rs[k0 + kk]; }
            tv[i] = v;
        }
#pragma unroll
        for (int i = 0; i < 16; ++i) tl[(ty + 4 * i) * 65 + tx] = tv[i];
        __syncthreads();
        const int rr = tid >> 2, c0 = (tid & 3) * 16;
        u32x4 o0, o1;
        o0.x = pk2(tl[(c0 + 0) * 65 + rr], tl[(c0 + 1) * 65 + rr]);   o0.y = pk2(tl[(c0 + 2) * 65 + rr], tl[(c0 + 3) * 65 + rr]);
        o0.z = pk2(tl[(c0 + 4) * 65 + rr], tl[(c0 + 5) * 65 + rr]);   o0.w = pk2(tl[(c0 + 6) * 65 + rr], tl[(c0 + 7) * 65 + rr]);
        o1.x = pk2(tl[(c0 + 8) * 65 + rr], tl[(c0 + 9) * 65 + rr]);   o1.y = pk2(tl[(c0 + 10) * 65 + rr], tl[(c0 + 11) * 65 + rr]);
        o1.z = pk2(tl[(c0 + 12) * 65 + rr], tl[(c0 + 13) * 65 + rr]); o1.w = pk2(tl[(c0 + 14) * 65 + rr], tl[(c0 + 15) * 65 + rr]);
        bf16_t* d = dst + (size_t)(n0 + rr) * K + k0 + c0;
        *(u32x4*)d = o0; *(u32x4*)(d + 8) = o1;
        __syncthreads();
    }
}
DI void cvt_job(const float* __restrict__ src, bf16_t* __restrict__ dst, size_t n8) {
    const size_t stride = (size_t)gridDim.x * 512;
    for (size_t i0 = (size_t)blockIdx.x * 512 + tid8_op(); i0 < n8; i0 += 4 * stride) {
        f32x4 a[4], b[4];
#pragma unroll
        for (int u = 0; u < 4; ++u) { const size_t i = i0 + u * stride; if (i < n8) { a[u] = *(const f32x4*)(src + i * 8); b[u] = *(const f32x4*)(src + i * 8 + 4); } }
#pragma unroll
        for (int u = 0; u < 4; ++u) { const size_t i = i0 + u * stride; if (i < n8) {
            u32x4 o; o.x = pk2(a[u].x, a[u].y); o.y = pk2(a[u].z, a[u].w); o.z = pk2(b[u].x, b[u].y); o.w = pk2(b[u].z, b[u].w);
            *(u32x4*)(dst + i * 8) = o; } }
    }
}
DI void prologue(const Params& p, unsigned char* smem) {
    unsigned char* ws = p.ws; asm volatile("" : "+s"(ws));
    { const int t0 = tid8_op(); if (blockIdx.x == 0 && t0 < 64) ((unsigned*)(ws + O_CNT))[t0] = 0u; }
    for (int l = 0; l < 4; ++l) {
        transpose_job(p.w_in + (size_t)l * 1024 * 3620, 3620, 1024, (bf16_t*)(ws + O_WIN + l * SZ_WIN), NIN, nullptr, true, smem);
        transpose_job(p.w_qb + (size_t)l * 384 * 384, 384, 384, (bf16_t*)(ws + O_WQB + l * SZ_WQB), 512, p.q_norm + l * 384, false, smem, 384);
        transpose_job(p.w_kvb + (size_t)l * 256 * 512, 512, 256, (bf16_t*)(ws + O_WKVB + l * SZ_WKVB), 512, p.kv_norm + l * 256, false, smem);
        transpose_job(p.w_mem_kv + (size_t)l * 1024 * 512, 512, 1024, (bf16_t*)(ws + O_WMEM + l * SZ_WMEM), 512, nullptr, false, smem);
        transpose_job(p.w_merge_up + (size_t)l * 128 * 4096, 4096, 128, (bf16_t*)(ws + O_WMU + l * SZ_WMU), 4096, nullptr, false, smem);
        transpose_job(p.w_branch + (size_t)l * 1024 * 1024, 1024, 1024, (bf16_t*)(ws + O_WBR + l * SZ_WBR), 1024, nullptr, false, smem);
        transpose_job(p.w_out + (size_t)l * 1024 * 1024, 1024, 1024, (bf16_t*)(ws + O_WOUT + l * SZ_WOUT), 1024, nullptr, false, smem);
    }
    cvt_job(p.x, (bf16_t*)(ws + O_XB), (size_t)T_ * 1024 / 8);
    cvt_job(p.mem, (bf16_t*)(ws + O_MEMB), (size_t)1024 * 1024 / 8);
    float* cs = (float*)(ws + O_COS); float* sn = (float*)(ws + O_SIN);
    for (int idx = blockIdx.x * 512 + tid8_op(); idx < T_ * 16; idx += gridDim.x * 512) {
        const int t = idx >> 4, i = idx & 15;
        const float inv = (float)exp2(-(double)i * (2.0 / 32.0) * 13.287712379549449);
        const float ang = (float)p.pos[t] * inv;
        const double rr = (double)ang - 6.283185307179586476925 * rint((double)ang * 0.15915494309189533577);
        const float rf = (float)rr;
        cs[idx] = cosf(rf); sn[idx] = sinf(rf);
    }
}

namespace pg8 {
#define PG8_LAS __attribute__((address_space(3)))
typedef unsigned short bf16_t;
typedef short bf16x8 __attribute__((ext_vector_type(8)));
typedef float f32x4 __attribute__((ext_vector_type(4)));
typedef unsigned u32x4 __attribute__((ext_vector_type(4)));
constexpr int BM = 256, BK = 64, HALF = 128, HTB = HALF * BK * 2  , STAGE_BYTES = 8 * HTB, NXCD = 8, WGM = 8;

__host__ __device__ __forceinline__ int lds_byte(int r, int c) { const int st = (r >> 4) * 2 + (c >> 5), rr = r & 15, cc = c & 31, ob = rr * 64 + cc * 2; return st * 1024 + (ob ^ (((ob >> 9) & 1) << 5)); }
__host__ __device__ __forceinline__ void stage_rc(int b, int& R, int& C) { const int st = b / 1024, sb = b % 1024, swz = sb ^ (((sb >> 9) & 1) << 5); R = (st >> 1) * 16 + swz / 64; C = (st & 1) * 32 + (swz % 64) / 2; }
__host__ __device__ __forceinline__ int perm32(int rho) { const int n = rho >> 4, i = rho & 15; return 8 * (i >> 2) + 4 * n + (i & 3); }

struct Unit { int pm, pn; };
struct Gemm { const bf16_t* A; const bf16_t* Bt; int M, N, K; };

struct StaticOrder {
    int nM, nN, nwg, G, c;
    __host__ __device__ void init(int M, int N, int G_, int c_) { nM = M / BM; nN = N / BM; nwg = nM * nN; G = G_; c = c_; }
    __host__ __device__ bool next(int i, Unit& u) const {
        const long L = (long)i * G + c; if (L >= nwg) return false;
        int wgid = (int)L; { const int q = nwg / NXCD, r = nwg % NXCD, xcd = wgid % NXCD, off = wgid / NXCD; wgid = (xcd < r ? xcd * (q + 1) : r * (q + 1) + (xcd - r) * q) + off; }
        const int nig = WGM * nN, gid = wgid / nig, fm = gid * WGM, gsz = (nM - fm) < WGM ? (nM - fm) : WGM;
        u.pm = fm + ((wgid % nig) % gsz); u.pn = (wgid % nig) / gsz; return true;
    }
    __device__ __forceinline__ void a_ready(const Unit&) const {}
    __device__ __forceinline__ void done(const Unit&) const {}
};

template <class Epi, class Sched, bool ALIGN_EPI = false, bool SP2 = false>
__device__ __forceinline__ void gemm_phase(PG8_LAS unsigned char* lds, const Gemm g, const Sched& S, const Epi& E) {
    const int tid = ::tid8_op(), wid = __builtin_amdgcn_readfirstlane(tid >> 6), lane = tid & 63, wr = wid >> 2, wc = wid & 3, fr = lane & 15, fq = lane >> 4;
    const int K = g.K, nt = K / BK;
    unsigned voffA[2], voffB[2];
#pragma unroll
    for (int i = 0; i < 2; ++i) { int R, C; stage_rc(tid * 16 + i * 8192, R, C); const int Rb = Epi::PERM ? ((R & ~31) + perm32(R & 31)) : R;
        voffA[i] = (unsigned)(R * K + C) * 2u; voffB[i] = (unsigned)(Rb * K + C) * 2u; }
    const size_t kstep = (size_t)(BK * 2);
    const size_t hstep = (size_t)HALF * K * 2;
    const size_t tstep = 2 * hstep;
    const unsigned ldsw = (unsigned)wid * 1024u;
    const int aoff = lds_byte(wr * 64 + fr, fq * 8), boff = lds_byte(wc * 32 + fr, fq * 8);
#define PG8_SA(b, h) (((b) * 2 + (h)) * HTB)
#define PG8_SB(b, h) ((4 + (b) * 2 + (h)) * HTB)
#define PG8_STAGE(bufoff, gbase, voff) do { _Pragma("unroll") for (int _i = 0; _i < 2; ++_i) \
        __builtin_amdgcn_global_load_lds((const unsigned*)((const char*)(gbase) + (voff)[_i]), (PG8_LAS unsigned*)(lds + (bufoff) + ldsw + _i * 8192), 16, 0, 0); } while (0)
#define PG8_LDA(dst, b, h) do { _Pragma("unroll") for (int m = 0; m < 4; ++m) _Pragma("unroll") for (int k = 0; k < 2; ++k) dst[m][k] = *(const PG8_LAS bf16x8*)(lds + PG8_SA(b, h) + aoff + m * 2048 + k * 1024); } while (0)
#define PG8_LDB(dst, b, h) do { _Pragma("unroll") for (int n = 0; n < 2; ++n) _Pragma("unroll") for (int k = 0; k < 2; ++k) dst[n][k] = *(const PG8_LAS bf16x8*)(lds + PG8_SB(b, h) + boff + n * 2048 + k * 1024); } while (0)
#define PG8_MMA(ai, bj, At, Bt) do { __builtin_amdgcn_s_setprio(1); _Pragma("unroll") for (int m = 0; m < 4; ++m) _Pragma("unroll") for (int n = 0; n < 2; ++n) _Pragma("unroll") for (int k = 0; k < 2; ++k) \
        acc[ai][bj][m][n] = __builtin_amdgcn_mfma_f32_16x16x32_bf16(Bt[n][k], At[m][k], acc[ai][bj][m][n], 0, 0, 0); __builtin_amdgcn_s_setprio(0); } while (0)
#define PG8_WAIT_V(n) asm volatile("s_waitcnt vmcnt(" #n ")" ::: "memory")
#define PG8_WAIT_L(n) asm volatile("s_waitcnt lgkmcnt(" #n ")" ::: "memory")
#define PG8_BAR __builtin_amdgcn_s_barrier()
#define PG8_SCHED __builtin_amdgcn_sched_barrier(0)
    Unit cur, nxt; int ui = 0;
    if (!S.next(0, cur)) return;
    f32x4 acc[2][2][4][2];
#pragma unroll
    for (int a = 0; a < 2; ++a)
#pragma unroll
        for (int b = 0; b < 2; ++b)
#pragma unroll
            for (int m = 0; m < 4; ++m)
#pragma unroll
                for (int n = 0; n < 2; ++n) acc[a][b][m][n] = (f32x4){0.f, 0.f, 0.f, 0.f};
    bf16x8 At[4][2], B0[2][2], B1[2][2];
    const char* cA = (const char*)g.A + (size_t)cur.pm * tstep; const char* cB = (const char*)g.Bt + (size_t)cur.pn * tstep;
    S.a_ready(cur);
    if constexpr (SP2) {
        PG8_STAGE(PG8_SB(0, 0), cB, voffB); PG8_STAGE(PG8_SB(0, 1), cB + hstep, voffB); PG8_STAGE(PG8_SA(0, 0), cA, voffA); PG8_STAGE(PG8_SA(0, 1), cA + hstep, voffA);
        if (wr == 1) PG8_BAR;
        PG8_WAIT_V(2); PG8_BAR;
        PG8_STAGE(PG8_SB(1, 0), cB + kstep, voffB); PG8_STAGE(PG8_SA(1, 0), cA + kstep, voffA); PG8_STAGE(PG8_SB(1, 1), cB + hstep + kstep, voffB);
        PG8_WAIT_V(6); PG8_BAR;
    } else {
        PG8_STAGE(PG8_SB(0, 0), cB, voffB); PG8_STAGE(PG8_SA(0, 0), cA, voffA); PG8_STAGE(PG8_SB(0, 1), cB + hstep, voffB); PG8_STAGE(PG8_SA(0, 1), cA + hstep, voffA);
        if (wr == 1) PG8_BAR;
        PG8_WAIT_V(4); PG8_BAR;
        PG8_STAGE(PG8_SB(1, 0), cB + kstep, voffB); PG8_STAGE(PG8_SA(1, 0), cA + kstep, voffA); PG8_STAGE(PG8_SB(1, 1), cB + hstep + kstep, voffB);
        PG8_WAIT_V(6); PG8_BAR;
    }
    for (;;) {
        const bool has_next = S.next(ui + 1, nxt);
        const char* nA = has_next ? (const char*)g.A + (size_t)nxt.pm * tstep : cA; const char* nB = has_next ? (const char*)g.Bt + (size_t)nxt.pn * tstep : cB;
        for (int t = 0; t < nt; t += 2) {
            const bool last = (t == nt - 2);
            const char* a1 = cA + (size_t)(t + 1) * kstep;
            const char* a2 = last ? nA : cA + (size_t)(t + 2) * kstep; const char* b2 = last ? nB : cB + (size_t)(t + 2) * kstep;
            const char* a3 = a2 + kstep; const char* b3 = b2 + kstep;
            if (last && has_next) S.a_ready(nxt);
            if constexpr (SP2) {
            PG8_LDB(B0, 0, 0); PG8_LDB(B1, 0, 1); PG8_SCHED; PG8_LDA(At, 0, 0); PG8_STAGE(PG8_SA(1, 1), a1 + hstep, voffA);
            PG8_WAIT_V(8); PG8_WAIT_L(0); PG8_BAR; PG8_MMA(0, 0, At, B0); PG8_MMA(0, 1, At, B1); PG8_BAR; PG8_SCHED;
            PG8_LDA(At, 0, 1); PG8_STAGE(PG8_SB(0, 0), b2, voffB); PG8_STAGE(PG8_SB(0, 1), b2 + hstep, voffB); PG8_STAGE(PG8_SA(0, 0), a2, voffA);
            PG8_WAIT_V(8); PG8_WAIT_L(0); PG8_BAR; PG8_MMA(1, 0, At, B0); PG8_MMA(1, 1, At, B1); PG8_BAR; PG8_SCHED;
            PG8_LDB(B0, 1, 0); PG8_LDB(B1, 1, 1); PG8_SCHED; PG8_LDA(At, 1, 0); PG8_STAGE(PG8_SA(0, 1), a2 + hstep, voffA);
            PG8_WAIT_V(8); PG8_WAIT_L(0); PG8_BAR; PG8_MMA(0, 0, At, B0); PG8_MMA(0, 1, At, B1); PG8_BAR; PG8_SCHED;
            PG8_LDA(At, 1, 1); PG8_STAGE(PG8_SB(1, 0), b3, voffB); PG8_STAGE(PG8_SB(1, 1), b3 + hstep, voffB); PG8_STAGE(PG8_SA(1, 0), a3, voffA);
            PG8_WAIT_V(8); PG8_WAIT_L(0); PG8_BAR; PG8_MMA(1, 0, At, B0); PG8_MMA(1, 1, At, B1); PG8_BAR; PG8_SCHED;
            } else {
            PG8_LDB(B0, 0, 0); PG8_SCHED; PG8_LDA(At, 0, 0); PG8_STAGE(PG8_SA(1, 1), a1 + hstep, voffA);
            PG8_WAIT_L(8); PG8_BAR; PG8_WAIT_L(0); PG8_MMA(0, 0, At, B0); PG8_BAR; PG8_SCHED;
            PG8_LDB(B1, 0, 1); PG8_STAGE(PG8_SB(0, 0), b2, voffB);
            PG8_BAR; PG8_WAIT_L(0); PG8_MMA(0, 1, At, B1); PG8_BAR;
            PG8_LDA(At, 0, 1); PG8_STAGE(PG8_SA(0, 0), a2, voffA);
            PG8_BAR; PG8_WAIT_L(0); PG8_MMA(1, 0, At, B0); PG8_BAR; PG8_SCHED;
            PG8_STAGE(PG8_SB(0, 1), b2 + hstep, voffB);
            PG8_WAIT_V(6); PG8_BAR; PG8_MMA(1, 1, At, B1); PG8_BAR;
            PG8_LDB(B0, 1, 0); PG8_SCHED; PG8_LDA(At, 1, 0); PG8_STAGE(PG8_SA(0, 1), a2 + hstep, voffA);
            PG8_WAIT_L(8); PG8_BAR; PG8_WAIT_L(0); PG8_MMA(0, 0, At, B0); PG8_BAR; PG8_SCHED;
            PG8_LDB(B1, 1, 1); PG8_STAGE(PG8_SB(1, 0), b3, voffB);
            PG8_BAR; PG8_WAIT_L(0); PG8_MMA(0, 1, At, B1); PG8_BAR;
            PG8_LDA(At, 1, 1); PG8_STAGE(PG8_SA(1, 0), a3, voffA);
            PG8_BAR; PG8_WAIT_L(0); PG8_MMA(1, 0, At, B0); PG8_BAR; PG8_SCHED;
            PG8_STAGE(PG8_SB(1, 1), b3 + hstep, voffB);
            PG8_WAIT_V(6); PG8_BAR; PG8_MMA(1, 1, At, B1); PG8_BAR;
            }
        }
        if constexpr (ALIGN_EPI) { if (wr == 0) PG8_BAR; }
        if constexpr (!Epi::AFTER_DRAIN) { E(acc, cur, wr, wc, fr, fq); S.done(cur); }
        if (!has_next) break;
#pragma unroll
        for (int a = 0; a < 2; ++a)
#pragma unroll
            for (int b = 0; b < 2; ++b)
#pragma unroll
                for (int m = 0; m < 4; ++m)
#pragma unroll
                    for (int n = 0; n < 2; ++n) acc[a][b][m][n] = (f32x4){0.f, 0.f, 0.f, 0.f};
        cur = nxt; cA = nA; cB = nB; ++ui;
        if constexpr (ALIGN_EPI) { if (wr == 1) PG8_BAR; }
    }
    PG8_WAIT_V(0);
    if constexpr (!ALIGN_EPI) { if (wr == 0) PG8_BAR; }
    PG8_BAR;
    if constexpr (Epi::AFTER_DRAIN) { E.fused(acc, cur, wr, wc, fr, fq, lds, wid, lane); S.done(cur); }
#undef PG8_SA
#undef PG8_SB
#undef PG8_STAGE
#undef PG8_LDA
#undef PG8_LDB
#undef PG8_MMA
#undef PG8_WAIT_V
#undef PG8_WAIT_L
#undef PG8_BAR
#undef PG8_SCHED
}
}

DI void p1_epi(const Params& p, int l, const f32x16 (&acc)[2][2], int row0, int cw, int r, int h) {
    unsigned char* ws = p.ws; asm volatile("" : "+s"(ws));
    const int b = row0 >> 13, s0 = row0 & (S_ - 1);
    if (cw < 384) st_rm(acc, (bf16_t*)(ws + O_CQ) + (size_t)row0 * 384 + cw, 384, 1.f, r, h);
    else if (cw < 640) st_rm(acc, (bf16_t*)(ws + O_CKV) + (size_t)row0 * 256 + (cw - 384), 256, 1.f, r, h);
    else if (cw < 2432) {
        int off, part; size_t o_q, o_k, o_vt;
        if (cw < 1408) { off = cw - 640; o_q = O_SBQ; o_k = O_SBK; o_vt = O_SBVT; }
        else if (cw < 2176) { off = cw - 1408; o_q = O_FQ; o_k = O_FK; o_vt = O_FVT; }
        else { off = cw - 2176; o_q = O_MEMQ; o_k = O_MEMQ; o_vt = O_MEMQ; }
        part = off >> 8; const int head = (off & 255) >> 6, bh = b * 4 + head;
        if (part == 0) st_rm(acc, (bf16_t*)(ws + o_q) + ((size_t)bh * S_ + s0) * 64, 64, 0.125f * LOG2E, r, h);
        else if (part == 1) st_rm(acc, (bf16_t*)(ws + o_k) + ((size_t)bh * S_ + s0) * 64, 64, 1.f, r, h);
        else st_tr(acc, (bf16_t*)(ws + o_vt) + (size_t)bh * 64 * S_ + s0, S_, 1.f, r, h);
    } else if (cw < 3456) {
        bf16_t* pb = (bf16_t*)(ws + O_GATE) + (size_t)(row0 + 4 * h) * 1024 + (cw - 2432) + r;
#pragma unroll
        for (int mi = 0; mi < 2; ++mi)
#pragma unroll
            for (int qd = 0; qd < 4; ++qd) {
                bf16_t* q = opaque(pb + (size_t)(32 * mi + 8 * qd) * 1024);
#pragma unroll
                for (int e = 0; e < 4; ++e)
#pragma unroll
                    for (int ni = 0; ni < 2; ++ni) {
                        const float v = acc[mi][ni][4 * qd + e];
                        q[e * 1024 + 32 * ni] = tobf(v * __builtin_amdgcn_rcpf(1.f + fexp2(-v * LOG2E)));
                    }
            }
    } else if (cw < 3584) st_rm(acc, (bf16_t*)(ws + O_MR) + (size_t)row0 * 128 + (cw - 3456), 128, 1.f, r, h);
    else if (cw == 3584) {
        float* pb = (float*)(ws + O_TAIL) + (size_t)(row0 + 4 * h) * 32 + r;
        float* pf = (float*)(ws + O_FL) + (size_t)(b * 4 + (r & 3)) * S_ + s0 + 4 * h;
        const float fb = p.fox_bias[l * 4 + (r & 3)];
#pragma unroll
        for (int mi = 0; mi < 2; ++mi)
#pragma unroll
            for (int qd = 0; qd < 4; ++qd) {
                float* q = opaque(pb + (size_t)(32 * mi + 8 * qd) * 32);
#pragma unroll
                for (int e = 0; e < 4; ++e) q[e * 32] = acc[mi][0][4 * qd + e];
                if (r < 4) {
                    f32x4 o;
#pragma unroll
                    for (int e = 0; e < 4; ++e) { const float xv = acc[mi][1][4 * qd + e] + fb; o[e] = (fminf(xv, 0.f) - log1pf(expf(-fabsf(xv)))) * LOG2E; }
                    *(f32x4*)(pf + 32 * mi + 8 * qd) = o;
                }
            }
    }
}
struct EpiP1 {
    static constexpr bool PERM = true, AFTER_DRAIN = false;
    unsigned char* ws;
    DI void operator()(const pg8::f32x4 (&acc)[2][2][4][2], const pg8::Unit& u, int wr, int wc, int fr, int fq) const {
        const int rowb = u.pm * 256 + wr * 64 + fr, b = (u.pm * 256) >> 13, c8 = 8 * fq;
#pragma unroll
        for (int bj = 0; bj < 2; ++bj) {
            const int cw = u.pn * 256 + bj * 128 + wc * 32;
            if (cw < 640 || cw >= 2432) {
                bf16_t* base; int ld; const bool silu = (cw >= 2432 && cw < 3456);
                if (cw < 384) { base = (bf16_t*)(ws + O_CQ) + cw; ld = 384; }
                else if (cw < 640) { base = (bf16_t*)(ws + O_CKV) + (cw - 384); ld = 256; }
                else if (cw < 3456) { base = (bf16_t*)(ws + O_GATE) + (cw - 2432); ld = 1024; }
                else { base = (bf16_t*)(ws + O_MR) + (cw - 3456); ld = 128; }
                bf16_t* pb = base + (size_t)rowb * ld + c8;
#pragma unroll
                for (int ai = 0; ai < 2; ++ai) {
                    bf16_t* q = opaque(pb + (size_t)(ai * 128) * ld);
#pragma unroll
                    for (int m = 0; m < 4; ++m) {
                        f32x4 v0 = acc[ai][bj][m][0], v1 = acc[ai][bj][m][1];
                        if (silu) {
#pragma unroll
                            for (int e = 0; e < 4; ++e) { v0[e] = v0[e] * __builtin_amdgcn_rcpf(1.f + fexp2(-v0[e] * LOG2E)); v1[e] = v1[e] * __builtin_amdgcn_rcpf(1.f + fexp2(-v1[e] * LOG2E)); }
                        }
                        u32x4 wv; wv.x = pk2(v0.x, v0.y); wv.y = pk2(v0.z, v0.w); wv.z = pk2(v1.x, v1.y); wv.w = pk2(v1.z, v1.w);
                        *(u32x4*)(q + (size_t)(m * 16) * ld) = wv;
                    }
                }
            } else {
                int off; size_t o_q, o_k, o_vt;
                if (cw < 1408) { off = cw - 640; o_q = O_SBQ; o_k = O_SBK; o_vt = O_SBVT; }
                else if (cw < 2176) { off = cw - 1408; o_q = O_FQ; o_k = O_FK; o_vt = O_FVT; }
                else { off = cw - 2176; o_q = O_MEMQ; o_k = O_MEMQ; o_vt = O_MEMQ; }
                const int part = off >> 8, head = (off & 255) >> 6, d0 = (off & 63) + c8, bh = b * 4 + head;
                const int s0 = rowb & (S_ - 1);
                if (part < 2) {
                    const float sc = part == 0 ? 0.125f * LOG2E : 1.f;
                    bf16_t* pb = (bf16_t*)(ws + (part == 0 ? o_q : o_k)) + ((size_t)bh * S_ + s0) * 64 + d0;
#pragma unroll
                    for (int ai = 0; ai < 2; ++ai) {
                        bf16_t* q = opaque(pb + (size_t)(ai * 128) * 64);
#pragma unroll
                        for (int m = 0; m < 4; ++m) {
                            const f32x4 v0 = acc[ai][bj][m][0] * sc, v1 = acc[ai][bj][m][1] * sc;
                            u32x4 wv; wv.x = pk2(v0.x, v0.y); wv.y = pk2(v0.z, v0.w); wv.z = pk2(v1.x, v1.y); wv.w = pk2(v1.z, v1.w);
                            *(u32x4*)(q + (m * 16) * 64) = wv;
                        }
                    }
                } else {
                    bf16_t* pb = (bf16_t*)(ws + o_vt) + ((size_t)bh * 64 + d0) * S_ + s0;
#pragma unroll
                    for (int ai = 0; ai < 2; ++ai)
#pragma unroll
                        for (int m = 0; m < 4; ++m) {
                            bf16_t* q = opaque(pb + ai * 128 + m * 16);
                            const f32x4 v0 = acc[ai][bj][m][0], v1 = acc[ai][bj][m][1];
                            q[0] = tobf(v0.x); q[(size_t)S_] = tobf(v0.y); q[(size_t)2 * S_] = tobf(v0.z); q[(size_t)3 * S_] = tobf(v0.w);
                            q[(size_t)4 * S_] = tobf(v1.x); q[(size_t)5 * S_] = tobf(v1.y); q[(size_t)6 * S_] = tobf(v1.z); q[(size_t)7 * S_] = tobf(v1.w);
                        }
                }
            }
        }
    }
};
DI void phase1(const Params& p, int l, unsigned char* smem) {
    unsigned char* ws = p.ws; asm volatile("" : "+s"(ws));
    const bf16_t* XB = (const bf16_t*)(ws + O_XB);
    const bf16_t* W = (const bf16_t*)(ws + O_WIN + l * SZ_WIN);
    {
        pg8::Gemm g; g.A = XB; g.Bt = W; g.M = T_; g.N = 3584; g.K = 1024;
        pg8::StaticOrder S; S.init(T_, 3584, (int)gridDim.x, (int)blockIdx.x);
        EpiP1 E; E.ws = ws;
        pg8::gemm_phase<EpiP1, pg8::StaticOrder, true, true>((PG8_LAS unsigned char*)smem, g, S, E);
    }
    {
        unsigned char* hs = smem + vhalf() * HALF_SMEM;
        const int t4 = tid_op(), lane4 = t4 & 63, w4 = t4 >> 6, wr4 = w4 >> 1, wc4 = w4 & 1, r4 = lane4 & 31, h4 = lane4 >> 5;
        for (int t = VB; t < 256; t += VG) {
            const int m0 = t * 128;
            f32x16 acc[2];
#pragma unroll
            for (int i = 0; i < 16; ++i) { acc[0][i] = 0.f; acc[1][i] = 0.f; }
            gemm_accum_n1(acc, XB + (size_t)m0 * 1024, 1024, W + (size_t)3584 * 1024, 1024, 16, hs);
            const int row0 = m0 + 64 * wr4, b = row0 >> 13, s0 = row0 & (S_ - 1);
            if (wc4 == 0) {
                float* pb = (float*)(ws + O_TAIL) + (size_t)(row0 + 4 * h4) * 32 + r4;
#pragma unroll
                for (int mi = 0; mi < 2; ++mi)
#pragma unroll
                    for (int qd = 0; qd < 4; ++qd) {
                        float* q = opaque(pb + (size_t)(32 * mi + 8 * qd) * 32);
#pragma unroll
                        for (int e = 0; e < 4; ++e) q[e * 32] = acc[mi][4 * qd + e];
                    }
            } else if (r4 < 4) {
                float* pf = (float*)(ws + O_FL) + (size_t)(b * 4 + r4) * S_ + s0 + 4 * h4;
                const float fb = p.fox_bias[l * 4 + r4];
#pragma unroll
                for (int mi = 0; mi < 2; ++mi)
#pragma unroll
                    for (int qd = 0; qd < 4; ++qd) {
                        f32x4 o;
#pragma unroll
                        for (int e = 0; e < 4; ++e) { const float xv = acc[mi][4 * qd + e] + fb; o[e] = (fminf(xv, 0.f) - log1pf(expf(-fabsf(xv)))) * LOG2E; }
                        *(f32x4*)(pf + 32 * mi + 8 * qd) = o;
                    }
            }
        }
        for (int t = VB - 256; t >= 0 && t < 32; t += VG) {
            const int m0 = (t >> 2) * 128, n0 = (t & 3) * 128;
            f32x16 acc[2][2]; zero4(acc);
            gemm_accum(acc, (const bf16_t*)(ws + O_MEMB) + (size_t)m0 * 1024, 1024, (const bf16_t*)(ws + O_WMEM + l * SZ_WMEM) + (size_t)n0 * 1024, 1024, 16, hs);
            const int row0 = m0 + 64 * wr4, b = row0 >> 8, j0 = row0 & 255, gc = n0 + 64 * wc4;
            if (gc < 256) st_rm(acc, (bf16_t*)(ws + O_MEMK) + ((size_t)(b * 4 + (gc >> 6)) * 256 + j0) * 64, 64, 1.f, r4, h4);
            else st_tr(acc, (bf16_t*)(ws + O_MEMVT) + (size_t)(b * 4 + ((gc - 256) >> 6)) * 64 * 256 + j0, 256, 1.f, r4, h4);
        }
    }
}

template <int K> DI void row_rstd(const bf16_t* A, float* rs) {
    const int tid = tid_op(), row = tid >> 1, half = tid & 1;
    constexpr int n = K / 2;
    const bf16_t* pr = A + (size_t)row * K + half * n;
    u32x4 v[n / 8];
#pragma unroll
    for (int j = 0; j < n / 8; ++j) v[j] = *(const u32x4*)(pr + 8 * j);
    float s = 0.f;
#pragma unroll
    for (int j = 0; j < n / 8; ++j) {
        float a;
        a = bflo(v[j].x); s += a * a; a = bfhi(v[j].x); s += a * a; a = bflo(v[j].y); s += a * a; a = bfhi(v[j].y); s += a * a;
        a = bflo(v[j].z); s += a * a; a = bfhi(v[j].z); s += a * a; a = bflo(v[j].w); s += a * a; a = bfhi(v[j].w); s += a * a;
    }
    s += __shfl_xor(s, 1);
    if (half == 0) rs[row] = rsqrtf(s / (float)K + 1e-6f);
}
template <int K> DI void row_rstd8(const bf16_t* A, float* rs) {
    const int tid = tid8_op(), row = tid >> 1, half = tid & 1;
    constexpr int n = K / 2;
    const bf16_t* pr = A + (size_t)row * K + half * n;
    float s = 0.f;
#pragma unroll 1
    for (int c = 0; c < n / 64; ++c) {
        u32x4 v[8];
#pragma unroll
        for (int j = 0; j < 8; ++j) v[j] = *(const u32x4*)(pr + 64 * c + 8 * j);
#pragma unroll
        for (int j = 0; j < 8; ++j) {
            float a;
            a = bflo(v[j].x); s += a * a; a = bfhi(v[j].x); s += a * a; a = bflo(v[j].y); s += a * a; a = bfhi(v[j].y); s += a * a;
            a = bflo(v[j].z); s += a * a; a = bfhi(v[j].z); s += a * a; a = bflo(v[j].w); s += a * a; a = bfhi(v[j].w); s += a * a;
        }
    }
    s += __shfl_xor(s, 1);
    if (half == 0) rs[row] = rsqrtf(s / (float)K + 1e-6f);
}
struct EpiQ {
    static constexpr bool PERM = true, AFTER_DRAIN = false;
    unsigned char* ws; const float* rs;
    DI void operator()(const pg8::f32x4 (&acc)[2][2][4][2], const pg8::Unit& u, int wr, int wc, int fr, int fq) const {
        asm volatile("" : "+v"(fr), "+v"(fq));
        const int rowb = u.pm * 256 + wr * 64 + fr, b = (u.pm * 256) >> 13, s0 = rowb & (S_ - 1), hh = fq >> 1;
        const float qs = 0.10206207261596575f * LOG2E;
        const float* COS = (const float*)(ws + O_COS); const float* SIN = (const float*)(ws + O_SIN);
#pragma unroll
        for (int bj = 0; bj < 2; ++bj) {
            const int c0 = u.pn * 256 + bj * 128 + wc * 32;
            if (c0 < 384) {
                const int head = c0 / 96, d0 = c0 - head * 96;
                bf16_t* pb = (bf16_t*)(ws + O_MQ) + ((size_t)(b * 4 + head) * S_ + s0) * 96 + d0 + 8 * fq;
#pragma unroll
                for (int ai = 0; ai < 2; ++ai)
#pragma unroll
                    for (int m = 0; m < 4; ++m) {
                        const int rl = ai * 128 + wr * 64 + m * 16 + fr;
                        const float sc = rs[rl] * qs;
                        f32x4 v0 = acc[ai][bj][m][0] * sc, v1 = acc[ai][bj][m][1] * sc;
                        if (d0 == 64) {
                            const float* pc = opaque(COS + (size_t)(rowb + ai * 128 + m * 16) * 16 + 8 * (fq & 1));
                            const float* ps = SIN + (pc - COS);
                            {   const f32x4 cv = *(const f32x4*)pc, sv = *(const f32x4*)ps; f32x4 pp;
#pragma unroll
                                for (int e = 0; e < 4; ++e) pp[e] = xhalf_other(v0[e], hh);
                                v0 = hh ? (v0 * cv + pp * sv) : (v0 * cv - pp * sv); }
                            {   const f32x4 cv = *(const f32x4*)(pc + 4), sv = *(const f32x4*)(ps + 4); f32x4 pp;
#pragma unroll
                                for (int e = 0; e < 4; ++e) pp[e] = xhalf_other(v1[e], hh);
                                v1 = hh ? (v1 * cv + pp * sv) : (v1 * cv - pp * sv); }
                        }
                        u32x4 wv; wv.x = pk2(v0.x, v0.y); wv.y = pk2(v0.z, v0.w); wv.z = pk2(v1.x, v1.y); wv.w = pk2(v1.z, v1.w);
                        *(u32x4*)(opaque(pb) + (size_t)(ai * 128 + m * 16) * 96) = wv;
                        asm volatile("" ::: "memory");
                    }
            }
        }
    }
};
struct EpiKV {
    static constexpr bool PERM = true, AFTER_DRAIN = false;
    unsigned char* ws; const float* rs;
    DI void operator()(const pg8::f32x4 (&acc)[2][2][4][2], const pg8::Unit& u, int wr, int wc, int fr, int fq) const {
        asm volatile("" : "+v"(fr), "+v"(fq));
        const int rowb = u.pm * 256 + wr * 64 + fr, b = (u.pm * 256) >> 13, s0 = rowb & (S_ - 1);
#pragma unroll
        for (int bj = 0; bj < 2; ++bj) {
            const int c0 = u.pn * 256 + bj * 128 + wc * 32, bh = b * 4 + (c0 >> 7), within = c0 & 127;
            if (within < 64) {
                bf16_t* pb = (bf16_t*)(ws + O_MK) + ((size_t)bh * S_ + s0) * 96 + within + 8 * fq;
#pragma unroll
                for (int ai = 0; ai < 2; ++ai)
#pragma unroll
                    for (int m = 0; m < 4; ++m) {
                        const float sc = rs[ai * 128 + wr * 64 + m * 16 + fr];
                        const f32x4 v0 = acc[ai][bj][m][0] * sc, v1 = acc[ai][bj][m][1] * sc;
                        u32x4 wv; wv.x = pk2(v0.x, v0.y); wv.y = pk2(v0.z, v0.w); wv.z = pk2(v1.x, v1.y); wv.w = pk2(v1.z, v1.w);
                        *(u32x4*)(opaque(pb) + (size_t)(ai * 128 + m * 16) * 96) = wv;
                        asm volatile("" ::: "memory");
                    }
            } else {
                bf16_t* pb = (bf16_t*)(ws + O_MVT) + ((size_t)bh * 64 + (within - 64) + 8 * fq) * S_ + s0;
#pragma unroll
                for (int ai = 0; ai < 2; ++ai)
#pragma unroll
                    for (int m = 0; m < 4; ++m) {
                        const float sc = rs[ai * 128 + wr * 64 + m * 16 + fr];
                        const f32x4 v0 = acc[ai][bj][m][0] * sc, v1 = acc[ai][bj][m][1] * sc;
                        bf16_t* q = opaque(pb + ai * 128 + m * 16);
                        q[0] = tobf(v0.x); q[(size_t)S_] = tobf(v0.y); q[(size_t)2 * S_] = tobf(v0.z); q[(size_t)3 * S_] = tobf(v0.w);
                        q[(size_t)4 * S_] = tobf(v1.x); q[(size_t)5 * S_] = tobf(v1.y); q[(size_t)6 * S_] = tobf(v1.z); q[(size_t)7 * S_] = tobf(v1.w);
                    }
            }
        }
    }
};
struct OneUnit {
    pg8::Unit u;
    __device__ __forceinline__ bool next(int i, pg8::Unit& o) const { if (i != 0) return false; o = u; return true; }
    __device__ __forceinline__ void a_ready(const pg8::Unit&) const {}
    __device__ __forceinline__ void done(const pg8::Unit&) const {}
};
DI void phase2_gemms(const Params& p, int l, unsigned char* smem0) {
    unsigned char* ws = p.ws; asm volatile("" : "+s"(ws));
    pg8::StaticOrder S; S.init(T_, 512, (int)gridDim.x, (int)blockIdx.x);
    float* rsq = (float*)(smem0 + 131072); float* rskv = rsq + 256;
    OneUnit O;
#pragma unroll 1
    for (int i = 0; S.next(i, O.u); ++i) {
        row_rstd8<384>((const bf16_t*)(ws + O_CQ) + (size_t)O.u.pm * 256 * 384, rsq);
        row_rstd8<256>((const bf16_t*)(ws + O_CKV) + (size_t)O.u.pm * 256 * 256, rskv);
        __syncthreads();
        { pg8::Gemm g; g.A = (const bf16_t*)(ws + O_CQ); g.Bt = (const bf16_t*)(ws + O_WQB + l * SZ_WQB); g.M = T_; g.N = 512; { int kk = 384; asm volatile("" : "+s"(kk)); g.K = kk; }
          EpiQ E; E.ws = ws; E.rs = rsq; pg8::gemm_phase<EpiQ, OneUnit, false, true>((PG8_LAS unsigned char*)smem0, g, O, E); }
        { pg8::Gemm g; g.A = (const bf16_t*)(ws + O_CKV); g.Bt = (const bf16_t*)(ws + O_WKVB + l * SZ_WKVB); g.M = T_; g.N = 512; { int kk = 256; asm volatile("" : "+s"(kk)); g.K = kk; }
          EpiKV E; E.ws = ws; E.rs = rskv; pg8::gemm_phase<EpiKV, OneUnit, false, true>((PG8_LAS unsigned char*)smem0, g, O, E); }
        __syncthreads();
    }
}
DI void phase2(const Params& p, int l, unsigned char* smem) {
    unsigned char* ws = p.ws; asm volatile("" : "+s"(ws));
    const int tid = tid_op(), lane = tid & 63, w = tid >> 6, wr = w >> 1, wc = w & 1, r = lane & 31, h = lane >> 5;
    float* rs = (float*)(smem + SMEM_RS);
    const float* COS = (const float*)(ws + O_COS); const float* SIN = (const float*)(ws + O_SIN);
    for (int nn = VB; nn < 272; nn += VG) {
        const int it = nn < 16 ? nn : (nn < 144 ? 1840 + (nn - 16) : 1968 + (nn - 144));
        __syncthreads();
        if (it >= 1968) {
            const int bh = (it - 1968) >> 3, ch = (it - 1968) & 7;
            const bf16_t* kp = (const bf16_t*)(ws + O_FK) + ((size_t)bh * S_ + ch * 1024 + tid * 4) * 64;
            u32x4 v[4][8];
#pragma unroll
            for (int j = 0; j < 4; ++j)
#pragma unroll
                for (int c = 0; c < 8; ++c) v[j][c] = *(const u32x4*)(kp + j * 64 + 8 * c);
            float mxn = 0.f;
#pragma unroll
            for (int j = 0; j < 4; ++j) {
                float q = 0.f;
#pragma unroll
                for (int c = 0; c < 8; ++c) { float a; a = bflo(v[j][c].x); q += a * a; a = bfhi(v[j][c].x); q += a * a; a = bflo(v[j][c].y); q += a * a; a = bfhi(v[j][c].y); q += a * a;
                    a = bflo(v[j][c].z); q += a * a; a = bfhi(v[j][c].z); q += a * a; a = bflo(v[j][c].w); q += a * a; a = bfhi(v[j][c].w); q += a * a; }
                mxn = fmaxf(mxn, q);
            }
#pragma unroll
            for (int d = 32; d >= 1; d >>= 1) mxn = fmaxf(mxn, __shfl_xor(mxn, d));
            if (lane == 0) atomicMax((unsigned*)(ws + O_KMAX) + bh, __float_as_uint(mxn));
        } else if (it < 16) {
            const float* fl = (const float*)(ws + O_FL) + (size_t)it * S_ + tid * 32;
            f32x4 v[8];
#pragma unroll
            for (int j = 0; j < 8; ++j) v[j] = *(const f32x4*)(fl + 4 * j);
            float sum = 0.f;
#pragma unroll
            for (int j = 0; j < 8; ++j) { sum += v[j].x; v[j].x = sum; sum += v[j].y; v[j].y = sum; sum += v[j].z; v[j].z = sum; sum += v[j].w; v[j].w = sum; }
            float inc = sum;
#pragma unroll
            for (int d = 1; d < 64; d <<= 1) { const float o = __shfl_up(inc, d); if (lane >= d) inc += o; }
            float* wt = (float*)smem;
            if (lane == 63) wt[w] = inc;
            __syncthreads();
            float pre = inc - sum;
            for (int k = 0; k < w; ++k) pre += wt[k];
            float* fc = (float*)(ws + O_FC) + (size_t)it * S_ + tid * 32;
#pragma unroll
            for (int j = 0; j < 8; ++j) *(f32x4*)(fc + 4 * j) = -(v[j] + pre);
        } else {
            const int tk = (it - 1840) * 256 + tid, b = tk >> 13, s = tk & (S_ - 1);
            const float* tl = (const float*)(ws + O_TAIL) + (size_t)tk * 32;
            float x1[16], x2[16], c[16], sn[16];
#pragma unroll
            for (int j = 0; j < 4; ++j) {
                const f32x4 a = *(const f32x4*)(tl + 4 * j), bb = *(const f32x4*)(tl + 16 + 4 * j);
                const f32x4 cc = *(const f32x4*)(COS + (size_t)tk * 16 + 4 * j), ss = *(const f32x4*)(SIN + (size_t)tk * 16 + 4 * j);
                x1[4 * j] = a.x; x1[4 * j + 1] = a.y; x1[4 * j + 2] = a.z; x1[4 * j + 3] = a.w;
                x2[4 * j] = bb.x; x2[4 * j + 1] = bb.y; x2[4 * j + 2] = bb.z; x2[4 * j + 3] = bb.w;
                c[4 * j] = cc.x; c[4 * j + 1] = cc.y; c[4 * j + 2] = cc.z; c[4 * j + 3] = cc.w;
                sn[4 * j] = ss.x; sn[4 * j + 1] = ss.y; sn[4 * j + 2] = ss.z; sn[4 * j + 3] = ss.w;
            }
            u32x4 o[4];
#pragma unroll
            for (int j = 0; j < 2; ++j) {
                u32x4 a, bb;
                a.x = pk2(x1[8 * j] * c[8 * j] - x2[8 * j] * sn[8 * j], x1[8 * j + 1] * c[8 * j + 1] - x2[8 * j + 1] * sn[8 * j + 1]);
                a.y = pk2(x1[8 * j + 2] * c[8 * j + 2] - x2[8 * j + 2] * sn[8 * j + 2], x1[8 * j + 3] * c[8 * j + 3] - x2[8 * j + 3] * sn[8 * j + 3]);
                a.z = pk2(x1[8 * j + 4] * c[8 * j + 4] - x2[8 * j + 4] * sn[8 * j + 4], x1[8 * j + 5] * c[8 * j + 5] - x2[8 * j + 5] * sn[8 * j + 5]);
                a.w = pk2(x1[8 * j + 6] * c[8 * j + 6] - x2[8 * j + 6] * sn[8 * j + 6], x1[8 * j + 7] * c[8 * j + 7] - x2[8 * j + 7] * sn[8 * j + 7]);
                bb.x = pk2(x1[8 * j] * sn[8 * j] + x2[8 * j] * c[8 * j], x1[8 * j + 1] * sn[8 * j + 1] + x2[8 * j + 1] * c[8 * j + 1]);
                bb.y = pk2(x1[8 * j + 2] * sn[8 * j + 2] + x2[8 * j + 2] * c[8 * j + 2], x1[8 * j + 3] * sn[8 * j + 3] + x2[8 * j + 3] * c[8 * j + 3]);
                bb.z = pk2(x1[8 * j + 4] * sn[8 * j + 4] + x2[8 * j + 4] * c[8 * j + 4], x1[8 * j + 5] * sn[8 * j + 5] + x2[8 * j + 5] * c[8 * j + 5]);
                bb.w = pk2(x1[8 * j + 6] * sn[8 * j + 6] + x2[8 * j + 6] * c[8 * j + 6], x1[8 * j + 7] * sn[8 * j + 7] + x2[8 * j + 7] * c[8 * j + 7]);
                o[j] = a; o[2 + j] = bb;
            }
#pragma unroll
            for (int hh = 0; hh < 4; ++hh) {
                bf16_t* d = (bf16_t*)(ws + O_MK) + ((size_t)(b * 4 + hh) * S_ + s) * 96 + 64;
                *(u32x4*)d = o[0]; *(u32x4*)(d + 8) = o[1]; *(u32x4*)(d + 16) = o[2]; *(u32x4*)(d + 24) = o[3];
            }
        }
    }
}

constexpr int ATT_BUF = 22784;
template <int DQK, int MODE, bool DESC>
DI void attn_item(const bf16_t* Q, const bf16_t* K, const bf16_t* VT, int ldv, const float* cdec, int q0, int ntiles, const bf16_t* gt, bf16_t* yb, unsigned char* smem, unsigned char* smem0, int hf, float kmax = 0.f) {
    constexpr int KS = DQK + 8, NKS = DQK / 16, KCH = DQK / 8, NKL = 64 * KCH / 256;
    const int tid = tid_op(), lane = tid & 63, w = tid >> 6, r = lane & 31, h = lane >> 5;
    const int qidx = q0 + 32 * w + r;
    bf16x8 qf[NKS];
#pragma unroll
    for (int s = 0; s < NKS; ++s) qf[s] = *(const bf16x8*)(Q + (size_t)(32 * w + r) * DQK + 16 * s + 8 * h);
    float qn = 0.f;
    if (MODE == 0 && DESC) {
#pragma unroll
        for (int s = 0; s < NKS; ++s)
#pragma unroll
            for (int j = 0; j < 8; ++j) { const float a = __uint_as_float(((unsigned)(unsigned short)qf[s][j]) << 16); qn += a * a; }
        qn += xhalf_other(qn, h);
        qn = sqrtf(qn) * kmax;
    }
    f32x16 o0, o1;
#pragma unroll
    for (int i = 0; i < 16; ++i) { o0[i] = 0.f; o1[i] = 0.f; }
    float m = -INFINITY, lsum = 0.f, R = 1.f;
    u32x4 rk[NKL], rv[2]; f32x4 rc = {0.f, 0.f, 0.f, 0.f};
    const unsigned okk = (unsigned)(((tid / KCH) * DQK + (tid % KCH) * 8) * 2);
    const unsigned ovv = (unsigned)(((tid >> 3) * ldv + (tid & 7) * 8) * 2), svv = (unsigned)(ldv * 64);
    auto ld_tile = [&](int kt) {
        const unsigned char* Kt = (const unsigned char*)(K + (size_t)(64 * kt) * DQK);
        const unsigned char* Vt = (const unsigned char*)(VT + 64 * kt);
#pragma unroll
        for (int j = 0; j < NKL; ++j) rk[j] = *(const u32x4*)(Kt + (okk + j * 4096));
#pragma unroll
        for (int j = 0; j < 2; ++j) rv[j] = *(const u32x4*)(Vt + (ovv + j * svv));
        if (cdec && tid < 16) rc = *(const f32x4*)(cdec + 64 * kt + 4 * tid);
    };
    auto st_tile = [&](int buf) {
        bf16_t* sK = (bf16_t*)(smem + buf * ATT_BUF); bf16_t* sV = (bf16_t*)(smem + buf * ATT_BUF + 13312); float* sC = (float*)(smem + buf * ATT_BUF + 22528);
#pragma unroll
        for (int j = 0; j < NKL; ++j) { const int c = tid + 256 * j, row = c / KCH, kc = (c % KCH) * 8; *(u32x4*)(sK + row * KS + kc) = rk[j]; }
#pragma unroll
        for (int j = 0; j < 2; ++j) { const int c = tid + 256 * j, row = c >> 3, kc = (c & 7) * 8; *(u32x4*)(sV + row * LS + kc) = rv[j]; }
        if (cdec && tid < 16) *(f32x4*)(sC + 4 * tid) = rc;
    };
    ld_tile(DESC ? ntiles - 1 : 0);
    __syncthreads();
    st_tile(0);
#pragma unroll 1
    for (int it = 0; it < ntiles; ++it) {
        const int kt = DESC ? ntiles - 1 - it : it, buf = it & 1;
        if (it + 1 < ntiles) ld_tile(DESC ? kt - 1 : kt + 1);
        __syncthreads();
        if ((MODE == 1 || (MODE == 0 && DESC)) && it > 0) {
            const int* fl = (const int*)(smem0 + SMEM_FLAG) + ((it - 1) & 1) * 8;
            if ((fl[0] & fl[1] & fl[2] & fl[3] & fl[4] & fl[5] & fl[6] & fl[7]) != 0) break;
        }
        const bf16_t* sK = (const bf16_t*)(smem + buf * ATT_BUF); const bf16_t* sV = (const bf16_t*)(smem + buf * ATT_BUF + 13312);
        const float* sC = (const float*)(smem + buf * ATT_BUF + 22528);
        bool active = true;
        if (MODE == 0) active = (64 * kt <= q0 + 32 * w + 31);
        if (MODE == 1) active = (64 * kt < q0 + 32 * w + 31);
        if (active) {
            f32x16 sc[2];
#pragma unroll
            for (int i = 0; i < 16; ++i) { sc[0][i] = 0.f; sc[1][i] = 0.f; }
#pragma unroll
            for (int s = 0; s < NKS; ++s) {
                const bf16x8 k0 = *(const bf16x8*)(sK + r * KS + 16 * s + 8 * h), k1 = *(const bf16x8*)(sK + (32 + r) * KS + 16 * s + 8 * h);
                sc[0] = MFMA32(k0, qf[s], sc[0]);
                sc[1] = MFMA32(k1, qf[s], sc[1]);
            }
            bf16x8 pf[4];
            if (MODE == 1) {
                float u[2][16];
#pragma unroll
                for (int mt = 0; mt < 2; ++mt)
#pragma unroll
                    for (int i = 0; i < 16; ++i) sc[mt][i] = __builtin_amdgcn_rcpf(1.f + fexp2(-sc[mt][i]));
                if (64 * kt + 63 >= q0 + 32 * w) {
#pragma unroll
                    for (int mt = 0; mt < 2; ++mt)
#pragma unroll
                        for (int i = 0; i < 16; ++i)
                            if (!(64 * kt + 32 * mt + crow(i, h) < qidx)) sc[mt][i] = 0.f;
                }
#pragma unroll
                for (int mt = 0; mt < 2; ++mt)
#pragma unroll
                    for (int i = 0; i < 16; ++i) u[mt][i] = 1.f - sc[mt][i];
                float p23[2][4], gs[2][4], go[2][4];
#pragma unroll
                for (int mt = 0; mt < 2; ++mt)
#pragma unroll
                    for (int qd = 0; qd < 4; ++qd) {
                        p23[mt][qd] = u[mt][4 * qd + 2] * u[mt][4 * qd + 3];
                        gs[mt][qd] = (u[mt][4 * qd] * u[mt][4 * qd + 1]) * p23[mt][qd];
                        go[mt][qd] = xhalf_other(gs[mt][qd], h);
                    }
                float run = R;
#pragma unroll
                for (int mt = 1; mt >= 0; --mt)
#pragma unroll
                    for (int qd = 3; qd >= 0; --qd) {
                        const float ex = h ? run : run * go[mt][qd];
                        run *= gs[mt][qd] * go[mt][qd];
                        const float e2 = ex * u[mt][4 * qd + 3], e1 = ex * p23[mt][qd], e0 = e1 * u[mt][4 * qd + 1];
                        sc[mt][4 * qd + 3] *= ex; sc[mt][4 * qd + 2] *= e2; sc[mt][4 * qd + 1] *= e1; sc[mt][4 * qd] *= e0;
                    }
                R = run;
            } else {
                f32x4 s4[2][4];
#pragma unroll
                for (int mt = 0; mt < 2; ++mt) {
                    s4[mt][0] = __builtin_shufflevector(sc[mt], sc[mt], 0, 1, 2, 3);
                    s4[mt][1] = __builtin_shufflevector(sc[mt], sc[mt], 4, 5, 6, 7);
                    s4[mt][2] = __builtin_shufflevector(sc[mt], sc[mt], 8, 9, 10, 11);
                    s4[mt][3] = __builtin_shufflevector(sc[mt], sc[mt], 12, 13, 14, 15);
                }
                if (cdec) {
#pragma unroll
                    for (int mt = 0; mt < 2; ++mt)
#pragma unroll
                        for (int qd = 0; qd < 4; ++qd) s4[mt][qd] += *(const f32x4*)(sC + 32 * mt + 8 * qd + 4 * h);
                }
                if (MODE == 0 && (64 * kt + 63 > q0 + 32 * w)) {
#pragma unroll
                    for (int mt = 0; mt < 2; ++mt)
#pragma unroll
                        for (int qd = 0; qd < 4; ++qd)
#pragma unroll
                            for (int e = 0; e < 4; ++e)
                                if (64 * kt + 32 * mt + 8 * qd + 4 * h + e > qidx) s4[mt][qd][e] = -INFINITY;
                }
                float mx = fmaxf(s4[0][0].x, s4[1][0].x);
#pragma unroll
                for (int qd = 0; qd < 4; ++qd) {
                    mx = fmaxf(fmaxf(mx, s4[0][qd].y), s4[1][qd].y);
                    mx = fmaxf(fmaxf(mx, s4[0][qd].z), s4[1][qd].z);
                    mx = fmaxf(fmaxf(mx, s4[0][qd].w), s4[1][qd].w);
                    if (qd < 3) mx = fmaxf(fmaxf(mx, s4[0][qd + 1].x), s4[1][qd + 1].x);
                }
                mx = xhalf_max(mx);
                const float mn = fmaxf(m, mx), alpha = fexp2(m - mn);
                m = mn;
                f32x4 ps4 = {0.f, 0.f, 0.f, 0.f};
                const float nmn = -mn;
                const f32x4 nm4 = {nmn, nmn, nmn, nmn};
                if (__builtin_amdgcn_ballot_w64(alpha != 1.f) != 0) { o0 *= alpha; o1 *= alpha; }
#pragma unroll
                for (int s2 = 0; s2 < 4; ++s2) {
                    const int mt = s2 >> 1, s = s2 & 1;
                    f32x4 da = s4[mt][2 * s] + nm4, db = s4[mt][2 * s + 1] + nm4;
                    da.x = fexp2(da.x); da.y = fexp2(da.y); da.z = fexp2(da.z); da.w = fexp2(da.w);
                    db.x = fexp2(db.x); db.y = fexp2(db.y); db.z = fexp2(db.z); db.w = fexp2(db.w);
                    ps4 += da; ps4 += db;
                    u32x4 pp;
                    pp.x = pk2(da.x, da.y); pp.y = pk2(da.z, da.w); pp.z = pk2(db.x, db.y); pp.w = pk2(db.z, db.w);
                    const bf16x8 pfr = __builtin_bit_cast(bf16x8, pp);
                    const s16x4 a0 = *(const s16x4*)(sV + r * LS + 16 * s2 + 4 * h), a1 = *(const s16x4*)(sV + r * LS + 16 * s2 + 8 + 4 * h);
                    const s16x4 b0 = *(const s16x4*)(sV + (32 + r) * LS + 16 * s2 + 4 * h), b1 = *(const s16x4*)(sV + (32 + r) * LS + 16 * s2 + 8 + 4 * h);
                    const bf16x8 v0 = __builtin_shufflevector(a0, a1, 0, 1, 2, 3, 4, 5, 6, 7), v1 = __builtin_shufflevector(b0, b1, 0, 1, 2, 3, 4, 5, 6, 7);
                    o0 = MFMA32(v0, pfr, o0);
                    o1 = MFMA32(v1, pfr, o1);
                }
                lsum = lsum * alpha + ((ps4.x + ps4.y) + (ps4.z + ps4.w));
            }
            if (MODE == 1) {
#pragma unroll
            for (int mt = 0; mt < 2; ++mt)
#pragma unroll
                for (int s = 0; s < 2; ++s) {
                    u32x4 pp;
                    pp.x = pk2(sc[mt][8 * s], sc[mt][8 * s + 1]); pp.y = pk2(sc[mt][8 * s + 2], sc[mt][8 * s + 3]);
                    pp.z = pk2(sc[mt][8 * s + 4], sc[mt][8 * s + 5]); pp.w = pk2(sc[mt][8 * s + 6], sc[mt][8 * s + 7]);
                    pf[2 * mt + s] = __builtin_bit_cast(bf16x8, pp);
                }
#pragma unroll
            for (int s2 = 0; s2 < 4; ++s2) {
                const s16x4 a0 = *(const s16x4*)(sV + r * LS + 16 * s2 + 4 * h), a1 = *(const s16x4*)(sV + r * LS + 16 * s2 + 8 + 4 * h);
                const s16x4 b0 = *(const s16x4*)(sV + (32 + r) * LS + 16 * s2 + 4 * h), b1 = *(const s16x4*)(sV + (32 + r) * LS + 16 * s2 + 8 + 4 * h);
                const bf16x8 v0 = __builtin_shufflevector(a0, a1, 0, 1, 2, 3, 4, 5, 6, 7), v1 = __builtin_shufflevector(b0, b1, 0, 1, 2, 3, 4, 5, 6, 7);
                o0 = MFMA32(v0, pf[s2], o0);
                o1 = MFMA32(v1, pf[s2], o1);
            }
            }
        }
        if (MODE == 1) {
            const int done = (__builtin_amdgcn_ballot_w64(R != 0.f) == 0) ? 1 : 0;
            if (lane == 0) ((int*)(smem0 + SMEM_FLAG))[(it & 1) * 8 + hf * 4 + w] = done;
        }
        if (MODE == 0 && DESC) {
            const float ncl = (kt > 0) ? cdec[64 * kt - 1] : 0.f;
            const bool live = !(qn + ncl - m < -152.f);
            const int done = (__builtin_amdgcn_ballot_w64(live) == 0) ? 1 : 0;
            if (lane == 0) ((int*)(smem0 + SMEM_FLAG))[(it & 1) * 8 + hf * 4 + w] = done;
        }
        if (it + 1 < ntiles) st_tile(buf ^ 1);
    }
    if (MODE != 1) {
        const float lt = lsum + xhalf_other(lsum, h), inv = __builtin_amdgcn_rcpf(lt);
        o0 *= inv; o1 *= inv;
    }
    bf16_t* yrow = yb + (size_t)(32 * w + r) * 1024 + 4 * h;
    const bf16_t* grow = gt + (size_t)(32 * w + r) * 1024 + 4 * h;
    u32x2 gv[2][4];
#pragma unroll
    for (int nt = 0; nt < 2; ++nt)
#pragma unroll
        for (int qd = 0; qd < 4; ++qd) gv[nt][qd] = *(const u32x2*)(grow + 32 * nt + 8 * qd);
#pragma unroll
    for (int nt = 0; nt < 2; ++nt)
#pragma unroll
        for (int qd = 0; qd < 4; ++qd) {
            const u32x2 g = gv[nt][qd];
            const f32x16& o = nt ? o1 : o0;
            u32x2 v;
            v.x = pk2(o[4 * qd] * bflo(g.x), o[4 * qd + 1] * bfhi(g.x));
            v.y = pk2(o[4 * qd + 2] * bflo(g.y), o[4 * qd + 3] * bfhi(g.y));
            *(u32x2*)(yrow + 32 * nt + 8 * qd) = v;
        }
}
DI void phase3(const Params& p, int l, unsigned char* smem, unsigned char* smem0) {
    unsigned char* ws = p.ws; asm volatile("" : "+s"(ws));
    unsigned* cnt = (unsigned*)(ws + O_CNT) + l * 8;
    int* s_item = (int*)(smem0 + SMEM_ITEM);
    const bf16_t* GATE = (const bf16_t*)(ws + O_GATE);
    bf16_t* YBo = (bf16_t*)(ws + O_YB);
    const int myx = (int)(xb_xcc_id() & 7u), hf = vhalf();
    int vict = 0;
    while (true) {
        __syncthreads();
        if (threadIdx.x == 0) {
            int code = -1;
            while (vict < 8) {
                const int x = (myx + vict) & 7;
                const unsigned idx = atomicAdd(cnt + x, 1u);
                if (idx < 256u) { code = x * 256 + (int)idx; break; }
                ++vict;
            }
            *s_item = code;
        }
        __syncthreads();
        const int code = *s_item;
        if (code < 0) break;
        const int x = code >> 8, idx = code & 255, bh = x + 8 * hf, b = bh >> 2, head = bh & 3;
        if (idx < 192) {
            const int qb = 63 - idx / 3, br = idx % 3, q0 = qb * 128, nt = 2 * qb + 2;
            if (br == 0) {
                attn_item<64, 1, true>((const bf16_t*)(ws + O_SBQ) + ((size_t)bh * S_ + q0) * 64, (const bf16_t*)(ws + O_SBK) + (size_t)bh * S_ * 64,
                                 (const bf16_t*)(ws + O_SBVT) + (size_t)bh * 64 * S_, S_, nullptr, q0, nt, GATE + ((size_t)b * S_ + q0) * 1024 + 256 + head * 64, YBo + ((size_t)b * S_ + q0) * 1024 + 256 + head * 64, smem, smem0, hf);
            } else if (br == 1) {
                attn_item<96, 0, false>((const bf16_t*)(ws + O_MQ) + ((size_t)bh * S_ + q0) * 96, (const bf16_t*)(ws + O_MK) + (size_t)bh * S_ * 96,
                                 (const bf16_t*)(ws + O_MVT) + (size_t)bh * 64 * S_, S_, nullptr, q0, nt, GATE + ((size_t)b * S_ + q0) * 1024 + head * 64, YBo + ((size_t)b * S_ + q0) * 1024 + head * 64, smem, smem0, hf);
            } else {
                attn_item<64, 0, true>((const bf16_t*)(ws + O_FQ) + ((size_t)bh * S_ + q0) * 64, (const bf16_t*)(ws + O_FK) + (size_t)bh * S_ * 64,
                                 (const bf16_t*)(ws + O_FVT) + (size_t)bh * 64 * S_, S_, (const float*)(ws + O_FC) + (size_t)bh * S_, q0, nt,
                                 GATE + ((size_t)b * S_ + q0) * 1024 + 512 + head * 64, YBo + ((size_t)b * S_ + q0) * 1024 + 512 + head * 64, smem, smem0, hf,
                                 sqrtf(((const float*)(ws + O_KMAX))[bh]) * 1.0002f);
            }
        } else {
            const int qb = idx - 192, q0 = qb * 128;
            attn_item<64, 2, false>((const bf16_t*)(ws + O_MEMQ) + ((size_t)bh * S_ + q0) * 64, (const bf16_t*)(ws + O_MEMK) + (size_t)bh * 256 * 64,
                             (const bf16_t*)(ws + O_MEMVT) + (size_t)bh * 64 * 256, 256, nullptr, q0, 4, GATE + ((size_t)b * S_ + q0) * 1024 + 768 + head * 64, YBo + ((size_t)b * S_ + q0) * 1024 + 768 + head * 64, smem, smem0, hf);
        }
    }
}

struct Stg4 { u32x4 a[2]; u32x4 b[2]; };
DI void stg4_issue(Stg4& st, const bf16_t* A, unsigned oa, unsigned sa, const bf16_t* B, unsigned ob, unsigned sb) {
#pragma unroll
    for (int j = 0; j < 2; ++j) { st.a[j] = *(const u32x4*)((const unsigned char*)A + (oa + j * sa)); st.b[j] = *(const u32x4*)((const unsigned char*)B + (ob + j * sb)); }
}
DI void stg4_commit(const Stg4& st, bf16_t* sA, bf16_t* sB, int srow, int skc) {
#pragma unroll
    for (int j = 0; j < 2; ++j) { *(u32x4*)(sA + (srow + 64 * j) * LS + skc) = st.a[j]; *(u32x4*)(sB + (srow + 64 * j) * LS + skc) = st.b[j]; }
}
DI void phase4(const Params& p, int l, unsigned char* smem) {
    unsigned char* ws = p.ws; asm volatile("" : "+s"(ws));
    const int tid = tid8_op(), lane = tid & 63, w = __builtin_amdgcn_readfirstlane(tid >> 6), wr = w >> 2, wc = w & 3, r = lane & 31, h = lane >> 5;
    const bf16_t* YB = (const bf16_t*)(ws + O_YB); const bf16_t* MR = (const bf16_t*)(ws + O_MR);
    const bf16_t* WMU = (const bf16_t*)(ws + O_WMU + l * SZ_WMU); const bf16_t* WBR = (const bf16_t*)(ws + O_WBR + l * SZ_WBR);
    const int G = gridDim.x, ntl = 2048, vb = blockIdx.x;
    if (vb >= ntl) return;
    const int nmine = (ntl - vb + G - 1) / G, gmax = nmine * 24 - 1;
    bf16_t* sA = (bf16_t*)smem; bf16_t* sB = sA + 2 * TILE_E;
    const int srow = tid >> 3, skc = (tid & 7) * 8;
    const unsigned o128 = (unsigned)((srow * 128 + skc) * 2), s128 = 128u * 128u, o1024 = (unsigned)((srow * 1024 + skc) * 2), s1024 = 1024u * 128u;
    auto ISS = [&](Stg4& R, int g) {
        g = g < gmax ? g : gmax;
        const int i = g / 24, v = g - i * 24, n = v / 6, jj = v - n * 6;
        const int t = vb + i * G, xcd = t & 7, j = t >> 3, m0 = (32 * xcd + (j >> 3)) * 128, c0 = (j & 7) * 128;
        if (jj < 2) stg4_issue(R, MR + (size_t)m0 * 128 + jj * 64, o128, s128, WMU + (size_t)(n * 1024 + c0) * 128 + jj * 64, o128, s128);
        else stg4_issue(R, YB + (size_t)m0 * 1024 + n * 256 + (jj - 2) * 64, o1024, s1024, WBR + (size_t)c0 * 1024 + n * 256 + (jj - 2) * 64, o1024, s1024);
    };
    Stg4 R0, R1;
    ISS(R0, 0); ISS(R1, 1);
    stg4_commit(R0, sA, sB, srow, skc);
    ISS(R0, 2);
#pragma unroll 1
    for (int it = 0; it < nmine; ++it) {
        const int t = vb + it * G;
        const int xcd = t & 7, j = t >> 3, m0 = (32 * xcd + (j >> 3)) * 128, c0 = (j & 7) * 128;
        f32x16 mg[2];
#pragma unroll
        for (int i = 0; i < 16; ++i) { mg[0][i] = 0.f; mg[1][i] = 0.f; }
#pragma unroll 1
        for (int n = 0; n < 4; ++n) {
            const int g0 = it * 24 + n * 6;
            f32x16 g[2], y[2];
#pragma unroll
            for (int i = 0; i < 16; ++i) { g[0][i] = 0.f; g[1][i] = 0.f; y[0][i] = 0.f; y[1][i] = 0.f; }
            __syncthreads(); mma21(g, sA, sB, wr, wc, r, h); stg4_commit(R1, sA + TILE_E, sB + TILE_E, srow, skc); ISS(R1, g0 + 3);
            __syncthreads(); mma21(g, sA + TILE_E, sB + TILE_E, wr, wc, r, h); stg4_commit(R0, sA, sB, srow, skc); ISS(R0, g0 + 4);
#pragma unroll
            for (int mi = 0; mi < 2; ++mi)
#pragma unroll
                for (int i = 0; i < 16; ++i) g[mi][i] = __builtin_amdgcn_rcpf(1.f + fexp2(-g[mi][i] * LOG2E));
            __syncthreads(); mma21(y, sA, sB, wr, wc, r, h); stg4_commit(R1, sA + TILE_E, sB + TILE_E, srow, skc); ISS(R1, g0 + 5);
            __syncthreads(); mma21(y, sA + TILE_E, sB + TILE_E, wr, wc, r, h); stg4_commit(R0, sA, sB, srow, skc); ISS(R0, g0 + 6);
            __syncthreads(); mma21(y, sA, sB, wr, wc, r, h); stg4_commit(R1, sA + TILE_E, sB + TILE_E, srow, skc); ISS(R1, g0 + 7);
            __syncthreads(); mma21(y, sA + TILE_E, sB + TILE_E, wr, wc, r, h); stg4_commit(R0, sA, sB, srow, skc); ISS(R0, g0 + 8);
#pragma unroll
            for (int mi = 0; mi < 2; ++mi)
#pragma unroll
                for (int i = 0; i < 16; ++i) mg[mi][i] += g[mi][i] * y[mi][i];
        }
        bf16_t* pb = (bf16_t*)(ws + O_XB) + (size_t)(m0 + 64 * wr + 4 * h) * 1024 + c0 + 32 * wc + r;
#pragma unroll
        for (int mi = 0; mi < 2; ++mi)
#pragma unroll
            for (int qd = 0; qd < 4; ++qd) {
                bf16_t* q = opaque(pb + (size_t)(32 * mi + 8 * qd) * 1024);
#pragma unroll
                for (int e = 0; e < 4; ++e) q[e * 1024] = tobf(mg[mi][4 * qd + e]);
            }
        __builtin_amdgcn_s_waitcnt(0x0F70);
    }
}

struct EpiP5 {
    static constexpr bool PERM = true, AFTER_DRAIN = false;
    const float* x; float* out; const float* st; const float* lg; const float* lb; int l;
    DI void operator()(const pg8::f32x4 (&acc)[2][2][4][2], const pg8::Unit& u, int wr, int wc, int fr, int fq) const {
        const int rowb = u.pm * 256 + wr * 64 + fr;
#pragma unroll
        for (int bj = 0; bj < 2; ++bj) {
            const int col0 = u.pn * 256 + bj * 128 + wc * 32 + 8 * fq;
            f32x4 g0 = {1.f, 1.f, 1.f, 1.f}, g1 = g0, b0 = {0.f, 0.f, 0.f, 0.f}, b1 = b0;
            if (l > 0) { g0 = *(const f32x4*)(lg + col0); g1 = *(const f32x4*)(lg + col0 + 4); b0 = *(const f32x4*)(lb + col0); b1 = *(const f32x4*)(lb + col0 + 4); }
            const float* src = (l == 0) ? x : (const float*)out;
#pragma unroll
            for (int ai = 0; ai < 2; ++ai) {
                const size_t i0 = (size_t)(rowb + ai * 128) * 1024 + col0;
                const float* ps = opaque(src + i0);
                f32x4 xa[4], xb_[4]; f32x2 sv[4];
#pragma unroll
                for (int m = 0; m < 4; ++m) {
                    xa[m] = *(const f32x4*)(ps + (size_t)(m * 16) * 1024); xb_[m] = *(const f32x4*)(ps + (size_t)(m * 16) * 1024 + 4);
                    if (l > 0) sv[m] = *(const f32x2*)(st + 2 * (rowb + ai * 128 + m * 16));
                }
                float* po = opaque(out + i0);
#pragma unroll
                for (int m = 0; m < 4; ++m) {
                    f32x4 x0 = xa[m], x1 = xb_[m];
                    if (l > 0) { x0 = (x0 - sv[m].x) * sv[m].y * g0 + b0; x1 = (x1 - sv[m].x) * sv[m].y * g1 + b1; }
                    *(f32x4*)(po + (size_t)(m * 16) * 1024) = x0 * DN_ALPHA + acc[ai][bj][m][0];
                    *(f32x4*)(po + (size_t)(m * 16) * 1024 + 4) = x1 * DN_ALPHA + acc[ai][bj][m][1];
                }
            }
        }
    }
};
DI void phase5(const Params& p, int l, unsigned char* smem) {
    unsigned char* ws = p.ws; asm volatile("" : "+s"(ws));
    pg8::Gemm g; g.A = (const bf16_t*)(ws + O_XB); g.Bt = (const bf16_t*)(ws + O_WOUT + l * SZ_WOUT); g.M = T_; g.N = 1024; g.K = 1024;
    pg8::StaticOrder S; S.init(T_, 1024, (int)gridDim.x, (int)blockIdx.x);
    EpiP5 E; E.x = p.x; E.out = p.out; E.st = (const float*)(ws + O_STATS); E.lg = p.ln_g + (l > 0 ? (l - 1) * 1024 : 0); E.lb = p.ln_b + (l > 0 ? (l - 1) * 1024 : 0); E.l = l;
    pg8::gemm_phase<EpiP5, pg8::StaticOrder, true, true>((PG8_LAS unsigned char*)smem, g, S, E);
}

DI void phase6(const Params& p, int l) {
    unsigned char* ws = p.ws; asm volatile("" : "+s"(ws));
    const int tidq = tid_op(), lane = tidq & 63, w = tidq >> 6;
    const float* G = p.ln_g + l * 1024; const float* Bv = p.ln_b + l * 1024;
    f32x4 g[4], bb[4];
#pragma unroll
    for (int j = 0; j < 4; ++j) { g[j] = *(const f32x4*)(G + 256 * j + 4 * lane); bb[j] = *(const f32x4*)(Bv + 256 * j + 4 * lane); }
    const int nw = VG * 4;
    for (int row0 = VB * 4 + w; row0 < T_; row0 += 2 * nw) {
        f32x4 v[2][4];
#pragma unroll
        for (int u = 0; u < 2; ++u) {
            const int row = row0 + u * nw;
            if (row < T_) {
#pragma unroll
                for (int j = 0; j < 4; ++j) v[u][j] = *(const f32x4*)(p.out + (size_t)row * 1024 + 256 * j + 4 * lane);
            }
        }
#pragma unroll
        for (int u = 0; u < 2; ++u) {
            const int row = row0 + u * nw;
            if (row >= T_) continue;
            float* pr = p.out + (size_t)row * 1024;
            float s = 0.f;
#pragma unroll
            for (int j = 0; j < 4; ++j) s += (v[u][j].x + v[u][j].y) + (v[u][j].z + v[u][j].w);
#pragma unroll
            for (int d = 32; d >= 1; d >>= 1) s += __shfl_xor(s, d);
            const float mu = s * (1.f / 1024.f);
            float q = 0.f;
#pragma unroll
            for (int j = 0; j < 4; ++j) { const f32x4 d = v[u][j] - mu; q += (d.x * d.x + d.y * d.y) + (d.z * d.z + d.w * d.w); }
#pragma unroll
            for (int d = 32; d >= 1; d >>= 1) q += __shfl_xor(q, d);
            const float rstd = rsqrtf(q * (1.f / 1024.f) + 1e-5f);
            if (l == 3) {
#pragma unroll
                for (int j = 0; j < 4; ++j) *(f32x4*)(pr + 256 * j + 4 * lane) = (v[u][j] - mu) * rstd * g[j] + bb[j];
            } else {
                if (lane == 0) { f32x2 st = {mu, rstd}; *(f32x2*)((float*)(ws + O_STATS) + 2 * row) = st; }
                bf16_t* xb = (bf16_t*)(ws + O_XB) + (size_t)row * 1024;
#pragma unroll
                for (int j = 0; j < 4; ++j) {
                    const f32x4 y = (v[u][j] - mu) * rstd * g[j] + bb[j];
                    u32x2 o; o.x = pk2(y.x, y.y); o.y = pk2(y.z, y.w);
                    *(u32x2*)(xb + 256 * j + 4 * lane) = o;
                }
            }
        }
    }
}

#define XB_TMO      128
#define XB_XCNT(j)  (256  + 64 * (j))
#define XB_XSUB(j)  (1280 + 64 * (j))
#define XB_XGEN(j)  (2304 + 64 * (j))
#define XB_TOP      3328
#define XB_TOPGEN   3392
#define XCD_BAR_WORDS 3456
#define XB_SPIN_CAP (1u << 18)
#define LAS __attribute__((address_space(3)))
DI unsigned xb_ld(unsigned* p)              { return __hip_atomic_load(p, __ATOMIC_RELAXED, __HIP_MEMORY_SCOPE_AGENT); }
DI unsigned xb_add(unsigned* p, unsigned v) { return __hip_atomic_fetch_add(p, v, __ATOMIC_RELAXED, __HIP_MEMORY_SCOPE_AGENT); }
#define XB_SPIN(cond, bar) do { unsigned _sp = 0; while (cond) { __builtin_amdgcn_s_sleep(1); \
    if ((++_sp & 255u) == 0u) { if (xb_ld(&(bar)[XB_TMO])) break; if (_sp > XB_SPIN_CAP) { atomicAdd(&(bar)[XB_TMO], 1u); break; } } } } while (0)
struct XcdBarrier { unsigned* bar; unsigned x; volatile LAS unsigned* st; };
DI XcdBarrier xcd_barrier_post(unsigned* bar, volatile LAS unsigned* st) {
    XcdBarrier b; b.bar = bar; b.x = xb_xcc_id(); b.st = st;
    if (threadIdx.x == 0) (void)xb_add(&bar[XB_XCNT(b.x)], 1u);
    return b;
}
DI void xcd_barrier_complete(unsigned* bar, unsigned x, unsigned& nloc, unsigned& nx) {
    const unsigned G = gridDim.x * gridDim.y * gridDim.z;
    unsigned sum, cnt, mine, sp = 0u;
    for (;;) {
        sum = 0u; cnt = 0u; mine = 0u;
#pragma unroll
        for (unsigned j = 0; j < 16; ++j) { const unsigned c = xb_ld(&bar[XB_XCNT(j)]); sum += c; cnt += (c > 0u) ? 1u : 0u; mine = (j == x) ? c : mine; }
        if (sum == G) break;
        __builtin_amdgcn_s_sleep(1);
        if ((++sp & 255u) == 0u) { if (xb_ld(&bar[XB_TMO])) break; if (sp > XB_SPIN_CAP) { atomicAdd(&bar[XB_TMO], 1u); break; } }
    }
    nloc = mine > 0u ? mine : 1u; nx = cnt > 0u ? cnt : 1u;
}
DI void xcd_barrier(const XcdBarrier& b) {
    asm volatile("s_waitcnt vmcnt(0)" ::: "memory");
    __syncthreads();
    if (threadIdx.x == 0) {
        unsigned* bar = b.bar; asm volatile("" : "+s"(bar));
        const unsigned bx = xb_xcc_id();
        __builtin_amdgcn_s_waitcnt(0);
        unsigned nloc = b.st[0], nx = b.st[1];
        if (nloc == 0u) { xcd_barrier_complete(bar, bx, nloc, nx); b.st[0] = nloc; b.st[1] = nx; }
        const unsigned old = xb_add(&bar[XB_XSUB(bx)], 1u);
        const unsigned gen = old / nloc;
        if (old + 1u == (gen + 1u) * nloc) {
            __builtin_amdgcn_fence(__ATOMIC_RELEASE, "agent");
            asm volatile("s_waitcnt vmcnt(0)" ::: "memory");
            const unsigned og = xb_add(&bar[XB_TOP], 1u);
            const unsigned tg = og / nx;
            if (og + 1u == (tg + 1u) * nx) xb_add(&bar[XB_TOPGEN], 1u);
            else XB_SPIN(xb_ld(&bar[XB_TOPGEN]) == tg, bar);
            __builtin_amdgcn_fence(__ATOMIC_ACQUIRE, "agent");
            xb_add(&bar[XB_XGEN(bx)], 1u);
            asm volatile("s_waitcnt vmcnt(0)" ::: "memory");
        } else {
            XB_SPIN(xb_ld(&bar[XB_XGEN(bx)]) == gen, bar);
            __builtin_amdgcn_fence(__ATOMIC_ACQUIRE, "agent");
            asm volatile("s_waitcnt vmcnt(0)" ::: "memory");
        }
    }
    __syncthreads();
}

constexpr int SMEM_WG = 2 * HALF_SMEM;
#if MK_MULTI
template <int PH> __global__ void __launch_bounds__(512) phase_kernel(Params p, int l) {
    __shared__ __attribute__((aligned(16))) unsigned char smem[SMEM_WG];
    unsigned char* hs = smem + vhalf() * HALF_SMEM;
    if (PH == 0) prologue(p, hs);
    if (PH == 1) phase1(p, l, smem);
    if (PH == 2) { phase2_gemms(p, l, smem); phase2(p, l, hs); }
    if (PH == 3) phase3(p, l, hs, smem);
    if (PH == 4) phase4(p, l, smem);
    if (PH == 5) phase5(p, l, smem);
    if (PH == 6) phase6(p, l);
}
#else
__global__ void __launch_bounds__(512) mega_kernel(Params p) {
    __shared__ __attribute__((aligned(16))) unsigned char smem[SMEM_WG];
    __shared__ uint4 xb_words;
    cg::grid_group grid = cg::this_grid();
    if (p.ws == nullptr) grid.sync();
    if (threadIdx.x == 0) xb_words = make_uint4(0u, 0u, 0u, 0u);
    __syncthreads();
    const XcdBarrier xb = xcd_barrier_post((unsigned*)(p.ws + O_BAR), (volatile LAS unsigned*)&xb_words);
    unsigned char* hs = smem + vhalf() * HALF_SMEM;
    prologue(p, hs);
    xcd_barrier(xb);
    for (int l = 0; l < 4; ++l) {
        for (int rep = 0; rep < REP1; ++rep) { phase1(p, l, smem); xcd_barrier(xb); }
        for (int rep = 0; rep < REP2; ++rep) { phase2_gemms(p, l, smem); phase2(p, l, hs); xcd_barrier(xb); }
        for (int rep = 0; rep < REP3; ++rep) { phase3(p, l * REP3 + rep, hs, smem); xcd_barrier(xb); }
        for (int rep = 0; rep < REP4; ++rep) { phase4(p, l, smem); xcd_barrier(xb); }
        phase5(p, l, smem); xcd_barrier(xb);
        phase6(p, l);
        if (l < 3) xcd_barrier(xb);
    }
}
#endif

extern "C" void kernel_launch(void* const* d_in, const int* in_sizes, int n_in, void* d_out, int out_size, void* d_ws, size_t ws_size, hipStream_t stream) {
    Params p{};
    p.x = (const float*)d_in[0]; p.mem = (const float*)d_in[1]; p.pos = (const int*)d_in[2]; p.w_in = (const float*)d_in[3];
    p.q_norm = (const float*)d_in[4]; p.w_qb = (const float*)d_in[5]; p.kv_norm = (const float*)d_in[6]; p.w_kvb = (const float*)d_in[7];
    p.fox_bias = (const float*)d_in[8]; p.w_mem_kv = (const float*)d_in[9]; p.w_merge_up = (const float*)d_in[10]; p.w_branch = (const float*)d_in[11];
    p.w_out = (const float*)d_in[12]; p.ln_g = (const float*)d_in[13]; p.ln_b = (const float*)d_in[14];
    p.out = (float*)d_out; p.ws = (unsigned char*)d_ws;
    if (ws_size < O_END) { fprintf(stderr, "workspace too small: %zu < %zu\n", ws_size, (size_t)O_END); return; }
#if MK_MULTI
    const int G = 256;
    phase_kernel<0><<<G, 512, 0, stream>>>(p, 0);
    for (int l = 0; l < 4; ++l) {
        phase_kernel<1><<<G, 512, 0, stream>>>(p, l);
        phase_kernel<2><<<G, 512, 0, stream>>>(p, l);
        phase_kernel<3><<<G, 512, 0, stream>>>(p, l);
        phase_kernel<4><<<G, 512, 0, stream>>>(p, l);
        phase_kernel<5><<<G, 512, 0, stream>>>(p, l);
        phase_kernel<6><<<G, 512, 0, stream>>>(p, l);
    }
#else
    static int grid_blocks = 0;
    if (!grid_blocks) {
        int dev = 0, cus = 0, per_cu = 0;
        hipGetDevice(&dev);
        hipDeviceGetAttribute(&cus, hipDeviceAttributeMultiprocessorCount, dev);
        hipOccupancyMaxActiveBlocksPerMultiprocessor(&per_cu, mega_kernel, 512, 0);
        if (per_cu > 1) per_cu = 1;
        grid_blocks = cus * per_cu;
    }
    hipMemsetAsync((unsigned char*)d_ws + O_CNT, 0, O_YB - O_CNT, stream);
    void* args[] = {&p};
    hipError_t e = hipLaunchCooperativeKernel((void*)mega_kernel, dim3(grid_blocks), dim3(512), args, 0, stream);
    if (e != hipSuccess) fprintf(stderr, "cooperative launch failed: %s (grid %d)\n", hipGetErrorString(e), grid_blocks);
#endif
}
```
